# Optimizing an MI355X kernel written in HIP

```python
import math
import jax, jax.numpy as jnp
from jax import lax
import numpy as np

D_MODEL = 1024
BATCH = 4
SEQ = 8192
DEPTH = 1
DEC_BATCH = 32
DEC_SEQ = 4
PAST_LEN = 16384
PAGE_SIZE = 128

D_CONV = 512
CONV_WIDTH = 31
HEAD_DIM = 64
HEADS_PER_GROUP = 4
GROUPS = ((128, 1), (512, 4), (2048, 16))
N_ATT_HEADS = HEADS_PER_GROUP * len(GROUPS)
D_ATT = N_ATT_HEADS * HEAD_DIM
D_ATT_OUT = HEADS_PER_GROUP * HEAD_DIM
D_FF = ((8 * D_MODEL + 3 * 256 - 1) // (3 * 256)) * 256
D_PLE = 256
BLK = 128
N_IN = 2 * D_CONV + 3 * D_ATT + 2 * D_MODEL
EPS = 1e-6
NEG_INF = -1e30

kernel_name = "hybrid_conformer_dilated_attn_decode_step"


def _rms_norm(x, g):
    xf = x.astype(jnp.float32)
    y = xf * lax.rsqrt(jnp.mean(xf * xf, axis=-1, keepdims=True) + EPS)
    return (y * g.astype(jnp.float32)).astype(x.dtype)


def _layer_norm(x, g, b):
    xf = x.astype(jnp.float32)
    mu = jnp.mean(xf, axis=-1, keepdims=True)
    xc = xf - mu
    y = xc * lax.rsqrt(jnp.mean(xc * xc, axis=-1, keepdims=True) + EPS)
    return (y * g.astype(jnp.float32) + b.astype(jnp.float32)).astype(x.dtype)


def _alibi_slopes():
    return 2.0 ** (-8.0 * (jnp.arange(N_ATT_HEADS, dtype=jnp.float32) + 1.0) / N_ATT_HEADS)


def _dilated_prompt(q, k, v, slopes, window, dil):
    B, S, H, Dh = q.shape
    span = dil * BLK
    S_pad = -(-S // span) * span
    nb = S_pad // span
    pad = ((0, 0), (0, S_pad - S), (0, 0), (0, 0))

    def split(a):
        return jnp.pad(a, pad).reshape(B, nb, BLK, dil, H, Dh)

    def with_prev(a):
        prev = jnp.pad(a, ((0, 0), (1, 0), (0, 0), (0, 0), (0, 0), (0, 0)))[:, :-1]
        return jnp.concatenate([prev, a], axis=2)

    qb = split(q)
    kk = with_prev(split(k))
    vv = with_prev(split(v))
    s = jnp.einsum('bnqrhd,bnkrhd->bnrhqk', qb, kk,
                   preferred_element_type=jnp.float32) * (1.0 / math.sqrt(Dh))
    qi = jnp.arange(BLK)[:, None]
    ki = jnp.arange(2 * BLK)[None, :]
    dist = qi + BLK - ki
    band = (dist >= 0) & (dist <= window // dil)
    first = (jnp.arange(nb)[:, None, None] > 0) | (ki >= BLK)
    mask = band[None] & first
    bias = -slopes[:, None, None] * (dist * dil).astype(jnp.float32)[None]
    s = jnp.where(mask[None, :, None, None], s + bias[None, None, None], NEG_INF)
    m = jnp.max(s, axis=-1, keepdims=True)
    p = jnp.exp(s - m)
    l = jnp.sum(p, axis=-1, keepdims=True)
    p = p / l
    o = jnp.einsum('bnrhqk,bnkrhd->bnqrhd', p, vv.astype(jnp.float32))
    o = o.reshape(B, S_pad, H, Dh)[:, :S]
    lse = (m + jnp.log(l))[..., 0]
    lse = jnp.transpose(lse, (0, 1, 4, 2, 3)).reshape(B, S_pad, H)[:, :S]
    return o, lse


def _dilated_sample(q, k_all, v_all, slopes, window, dil, L):
    T = q.shape[1]
    Dh = q.shape[-1]
    j = jnp.arange(window // dil + 1)
    idx = L + jnp.arange(T)[:, None] - j[None, :] * dil
    valid = idx >= 0
    idx_c = jnp.maximum(idx, 0)
    kg = k_all[:, idx_c]
    vg = v_all[:, idx_c]
    s = jnp.einsum('bthd,btjhd->bhtj', q, kg,
                   preferred_element_type=jnp.float32) * (1.0 / math.sqrt(Dh))
    bias = -slopes[:, None, None] * (j * dil).astype(jnp.float32)[None, None, :]
    s = jnp.where(valid[None, None], s + bias[None], NEG_INF)
    m = jnp.max(s, axis=-1, keepdims=True)
    p = jnp.exp(s - m)
    l = jnp.sum(p, axis=-1, keepdims=True)
    p = p / l
    o = jnp.einsum('bhtj,btjhd->bthd', p, vg.astype(jnp.float32))
    lse = jnp.transpose((m + jnp.log(l))[..., 0], (0, 2, 1))
    return o, lse


def _mixer(h, conv_buf, kv_bufs, w_in, w_dw, b_dw, ln_g, ln_b, w_conv_out, w_att_out, w_out):
    B, S, _ = h.shape
    z = h @ w_in
    o_q = 2 * D_CONV
    o_k = o_q + D_ATT
    o_v = o_k + D_ATT
    o_g = o_v + D_ATT
    u = z[..., :D_CONV] * jax.nn.sigmoid(z[..., D_CONV:o_q])
    q = z[..., o_q:o_k].reshape(B, S, N_ATT_HEADS, HEAD_DIM)
    k = z[..., o_k:o_v].reshape(B, S, N_ATT_HEADS, HEAD_DIM)
    v = z[..., o_v:o_g].reshape(B, S, N_ATT_HEADS, HEAD_DIM)
    gate_c = jax.nn.sigmoid(z[..., o_g:o_g + D_MODEL])
    gate_a = jax.nn.sigmoid(z[..., o_g + D_MODEL:])

    if conv_buf is None:
        conv_buf = jnp.zeros((B, CONV_WIDTH - 1, D_CONV), u.dtype)
    xin = jnp.concatenate([conv_buf.astype(u.dtype), u], axis=1)
    new_conv = xin[:, -(CONV_WIDTH - 1):]
    c = lax.conv_general_dilated(xin, w_dw[:, None, :], (1,), 'VALID',
                                 dimension_numbers=('NWC', 'WIO', 'NWC'),
                                 feature_group_count=D_CONV) + b_dw
    c = jax.nn.silu(_layer_norm(c, ln_g, ln_b))
    y_conv = c @ w_conv_out

    slopes = _alibi_slopes()
    outs, lses, new_kv = [], [], []
    for g, (window, dil) in enumerate(GROUPS):
        hs = slice(g * HEADS_PER_GROUP, (g + 1) * HEADS_PER_GROUP)
        qg, kg, vg = q[:, :, hs], k[:, :, hs], v[:, :, hs]
        kv_new = jnp.stack([kg, vg], axis=2)
        if kv_bufs is None:
            o, lse = _dilated_prompt(qg, kg, vg, slopes[hs], window, dil)
            new_kv.append(kv_new[:, -min(window, S):])
        else:
            buf = kv_bufs[g].astype(kv_new.dtype)
            L = buf.shape[1]
            kv_all = jnp.concatenate([buf, kv_new], axis=1)
            o, lse = _dilated_sample(qg, kv_all[:, :, 0], kv_all[:, :, 1], slopes[hs], window, dil, L)
            new_kv.append(kv_all[:, -L:])
        outs.append(o)
        lses.append(lse)
    wts = jax.nn.softmax(jnp.stack(lses, axis=0), axis=0)
    o = jnp.sum(wts[..., None] * jnp.stack(outs, axis=0), axis=0)
    y_att = o.reshape(B, S, D_ATT_OUT).astype(h.dtype) @ w_att_out

    mix = (gate_c * y_conv + gate_a * y_att) @ w_out
    return mix, new_conv, new_kv


def _layer(x, p, conv_buf, kv_bufs, g_mix, w_in, w_dw, b_dw, ln_g, ln_b, w_conv_out, w_att_out,
           w_out, g_ffn, w_ffn_gate, w_ffn_up, w_ffn_down, g_ple, w_ple_gate, w_ple):
    mix, new_conv, new_kv = _mixer(_rms_norm(x, g_mix), conv_buf, kv_bufs, w_in, w_dw, b_dw,
                                   ln_g, ln_b, w_conv_out, w_att_out, w_out)
    x = x + mix
    hf = _rms_norm(x, g_ffn)
    x = x + (jax.nn.silu(hf @ w_ffn_gate) * (hf @ w_ffn_up)) @ w_ffn_down
    x = x + jax.nn.sigmoid(_rms_norm(x, g_ple) @ w_ple_gate) * (p.astype(x.dtype) @ w_ple)
    return x, new_conv, new_kv


def setup_inputs(seed: int = 0) -> dict:
    key = jax.random.key(seed)
    ks = iter(jax.random.split(key, 40))
    f32 = jnp.float32

    def nrm(shape, scale):
        return jax.random.normal(next(ks), shape, f32) * scale

    def gain(shape):
        return 1.0 + 0.01 * jax.random.normal(next(ks), shape, f32)

    d = {}
    d["x_prompt"] = nrm((BATCH, SEQ, D_MODEL), 1.0)
    d["x_sample"] = nrm((DEC_BATCH, DEC_SEQ, D_MODEL), 1.0)
    d["state_conv"] = nrm((DEPTH, DEC_BATCH, CONV_WIDTH - 1, D_CONV), 0.5)
    for g, (window, _) in enumerate(GROUPS):
        d["cache_kv_g%d" % g] = nrm((DEPTH, DEC_BATCH, min(window, PAST_LEN), 2, HEADS_PER_GROUP, HEAD_DIM), 1.0)
    d["p_prompt"] = nrm((DEPTH, BATCH, SEQ, D_PLE), 1.0)
    d["p_sample"] = nrm((DEPTH, DEC_BATCH, DEC_SEQ, D_PLE), 1.0)
    d["g_mix"] = gain((DEPTH, D_MODEL))
    d["w_in"] = nrm((DEPTH, D_MODEL, N_IN), D_MODEL ** -0.5)
    d["w_dw"] = nrm((DEPTH, CONV_WIDTH, D_CONV), CONV_WIDTH ** -0.5)
    d["b_dw"] = nrm((DEPTH, D_CONV), 0.01)
    d["ln_g"] = gain((DEPTH, D_CONV))
    d["ln_b"] = nrm((DEPTH, D_CONV), 0.01)
    d["w_conv_out"] = nrm((DEPTH, D_CONV, D_MODEL), D_CONV ** -0.5)
    d["w_att_out"] = nrm((DEPTH, D_ATT_OUT, D_MODEL), D_ATT_OUT ** -0.5)
    d["w_out"] = nrm((DEPTH, D_MODEL, D_MODEL), D_MODEL ** -0.5)
    d["g_ffn"] = gain((DEPTH, D_MODEL))
    d["w_ffn_gate"] = nrm((DEPTH, D_MODEL, D_FF), D_MODEL ** -0.5)
    d["w_ffn_up"] = nrm((DEPTH, D_MODEL, D_FF), D_MODEL ** -0.5)
    d["w_ffn_down"] = nrm((DEPTH, D_FF, D_MODEL), D_FF ** -0.5)
    d["g_ple"] = gain((DEPTH, D_MODEL))
    d["w_ple_gate"] = nrm((DEPTH, D_MODEL, D_MODEL), D_MODEL ** -0.5)
    d["w_ple"] = nrm((DEPTH, D_PLE, D_MODEL), D_PLE ** -0.5)
    d["g_final"] = gain((D_MODEL,))
    return d


def reference(x_prompt, x_sample, state_conv, cache_kv_g0, cache_kv_g1, cache_kv_g2, p_prompt, p_sample,
              g_mix, w_in, w_dw, b_dw, ln_g, ln_b, w_conv_out, w_att_out, w_out, g_ffn, w_ffn_gate,
              w_ffn_up, w_ffn_down, g_ple, w_ple_gate, w_ple, g_final):
    xp, xs = x_prompt, x_sample
    conv_p, conv_s = [], []
    kv_p = [[], [], []]
    kv_s = [[], [], []]
    for i in range(DEPTH):
        lw = (g_mix[i], w_in[i], w_dw[i], b_dw[i], ln_g[i], ln_b[i], w_conv_out[i], w_att_out[i],
              w_out[i], g_ffn[i], w_ffn_gate[i], w_ffn_up[i], w_ffn_down[i], g_ple[i], w_ple_gate[i], w_ple[i])
        xp, ncp, nkvp = _layer(xp, p_prompt[i], None, None, *lw)
        xs, ncs, nkvs = _layer(xs, p_sample[i], state_conv[i],
                               (cache_kv_g0[i], cache_kv_g1[i], cache_kv_g2[i]), *lw)
        conv_p.append(ncp)
        conv_s.append(ncs)
        for g in range(len(GROUPS)):
            kv_p[g].append(nkvp[g])
            kv_s[g].append(nkvs[g])
    y_prompt = _rms_norm(xp, g_final)
    y_sample = _rms_norm(xs, g_final)
    return (y_prompt, y_sample, jnp.stack(conv_p), jnp.stack(conv_s),
            jnp.stack(kv_p[0]), jnp.stack(kv_s[0]), jnp.stack(kv_p[1]), jnp.stack(kv_s[1]),
            jnp.stack(kv_p[2]), jnp.stack(kv_s[2]))
```

```cpp
#define MK_N_LAUNCHES 9
#include <hip/hip_runtime.h>
#include <cstdio>
#include <cstdint>

namespace cfg {
constexpr int DM = 1024, SEQ = 8192, NBATCH = 4, MP = NBATCH * SEQ, NSEQ = 32, NTOK = 4, MS = NSEQ * NTOK, MR = MP + MS, MPAD = 33024;
constexpr int DCONV = 512, NIN = 5376, DFF = 2816, DPLE = 256, CWID = 31;
constexpr float EPS = 1e-6f;
constexpr float C2 = 0.125f * 1.4426950408889634f;
constexpr size_t O_Y = 0;
constexpr size_t O_CONVP = (size_t)MR * DM;
constexpr size_t O_CONVS = O_CONVP + (size_t)4 * 30 * 512;
constexpr size_t O_KV0P = O_CONVS + (size_t)32 * 30 * 512;
constexpr size_t O_KV0S = O_KV0P + (size_t)4 * 128 * 512;
constexpr size_t O_KV1P = O_KV0S + (size_t)32 * 128 * 512;
constexpr size_t O_KV1S = O_KV1P + (size_t)4 * 512 * 512;
constexpr size_t O_KV2P = O_KV1S + (size_t)32 * 512 * 512;
constexpr size_t O_KV2S = O_KV2P + (size_t)4 * 2048 * 512;
constexpr size_t O_END = O_KV2S + (size_t)32 * 2048 * 512;
static_assert(O_END == 83783680, "output size");
}
namespace pg8 {
#define PG8_LAS __attribute__((address_space(3)))
typedef unsigned short bf16_t;
typedef short bf16x8 __attribute__((ext_vector_type(8)));
typedef float f32x4 __attribute__((ext_vector_type(4)));
typedef unsigned u32x4 __attribute__((ext_vector_type(4)));
constexpr int BM = 256, BK = 64, HALF = 128, HTB = HALF * BK * 2  , STAGE_BYTES = 8 * HTB, NXCD = 8, WGM = 8;

__host__ __device__ __forceinline__ int lds_byte(int r, int c) { const int st = (r >> 4) * 2 + (c >> 5), rr = r & 15, cc = c & 31, ob = rr * 64 + cc * 2; return st * 1024 + (ob ^ (((ob >> 9) & 1) << 5)); }
__host__ __device__ __forceinline__ void stage_rc(int b, int& R, int& C) { const int st = b / 1024, sb = b % 1024, swz = sb ^ (((sb >> 9) & 1) << 5); R = (st >> 1) * 16 + swz / 64; C = (st & 1) * 32 + (swz % 64) / 2; }
__host__ __device__ __forceinline__ int perm32(int rho) { const int n = rho >> 4, i = rho & 15; return 8 * (i >> 2) + 4 * n + (i & 3); }

struct Unit { int pm, pn; };
struct Gemm { const bf16_t* A; const bf16_t* Bt; int M, N, K; };

struct StaticOrder {
    int nM, nN, nwg, G, c;
    __host__ __device__ void init(int M, int N, int G_, int c_) { nM = M / BM; nN = N / BM; nwg = nM * nN; G = G_; c = c_; }
    __host__ __device__ bool next(int i, Unit& u) const {
        const long L = (long)i * G + c; if (L >= nwg) return false;
        int wgid = (int)L; { const int q = nwg / NXCD, r = nwg % NXCD, xcd = wgid % NXCD, off = wgid / NXCD; wgid = (xcd < r ? xcd * (q + 1) : r * (q + 1) + (xcd - r) * q) + off; }
        const int nig = WGM * nN, gid = wgid / nig, fm = gid * WGM, gsz = (nM - fm) < WGM ? (nM - fm) : WGM;
        u.pm = fm + ((wgid % nig) % gsz); u.pn = (wgid % nig) / gsz; return true;
    }
    __device__ __forceinline__ void a_ready(const Unit&) const {}
    __device__ __forceinline__ void done(const Unit&) const {}
};

typedef float f32x2c_t __attribute__((ext_vector_type(2))); typedef __bf16 bf16x2c_t __attribute__((ext_vector_type(2)));
__device__ __forceinline__ unsigned cvt_pk_bf16(float lo, float hi) { const f32x2c_t v = {lo, hi}; const bf16x2c_t b = __builtin_convertvector(v, bf16x2c_t); return __builtin_bit_cast(unsigned, b); }
typedef float f32x2 __attribute__((ext_vector_type(2)));
__device__ __forceinline__ float sigm(float x) { return __builtin_amdgcn_rcpf(1.0f + __builtin_amdgcn_exp2f(-1.4426950408889634f * x)); }
__device__ __forceinline__ u32x4 pack8(const f32x4 a, const f32x4 b) { u32x4 w; w.x = cvt_pk_bf16(a[0], a[1]); w.y = cvt_pk_bf16(a[2], a[3]); w.z = cvt_pk_bf16(b[0], b[1]); w.w = cvt_pk_bf16(b[2], b[3]); return w; }
__device__ __forceinline__ void unpack8(const u32x4 w, f32x4& a, f32x4& b) {
    a[0] = __uint_as_float(w.x << 16); a[1] = __uint_as_float(w.x & 0xffff0000u); a[2] = __uint_as_float(w.y << 16); a[3] = __uint_as_float(w.y & 0xffff0000u);
    b[0] = __uint_as_float(w.z << 16); b[1] = __uint_as_float(w.z & 0xffff0000u); b[2] = __uint_as_float(w.w << 16); b[3] = __uint_as_float(w.w & 0xffff0000u); }
__device__ __forceinline__ float dot4(const f32x4 a) { return (a[0] * a[0] + a[1] * a[1]) + (a[2] * a[2] + a[3] * a[3]); }
__device__ __forceinline__ float rstd16(const float* p) {
    const f32x4 a = *(const f32x4*)p, b = *(const f32x4*)(p + 4), c = *(const f32x4*)(p + 8), d = *(const f32x4*)(p + 12);
    const float s = (((a[0] + a[1]) + (a[2] + a[3])) + ((b[0] + b[1]) + (b[2] + b[3]))) + (((c[0] + c[1]) + (c[2] + c[3])) + ((d[0] + d[1]) + (d[2] + d[3])));
    return __builtin_amdgcn_rsqf(s * (1.0f / 1024.0f) + cfg::EPS);
}

struct EpiIn {
    static constexpr bool PERM = true, AFTER_DRAIN = false;
    const float* rstd; bf16_t *U, *Q, *Kb, *Vb, *GT; float* out;
    __device__ __forceinline__ void operator()(const f32x4 (&acc)[2][2][4][2], const Unit& u, int wr, int wc, int fr, int fq) const {
        using namespace cfg;
        const int pn = u.pn, rbase = u.pm * BM + wr * 64 + fr, cl = wc * 32 + 8 * fq, tb = u.pm & 31;
        const bool smp = (u.pm == MP / BM);
        if (pn < 4) {
            const bool hasout = smp || tb == 31;
#pragma unroll
            for (int ai = 0; ai < 2; ++ai)
#pragma unroll
                for (int m = 0; m < 4; ++m) {
                    const int row = rbase + ai * HALF + m * 16; const float rs = rstd[row];
                    f32x4 a0 = acc[ai][0][m][0] * rs, a1 = acc[ai][0][m][1] * rs; const f32x4 b0 = acc[ai][1][m][0] * rs, b1 = acc[ai][1][m][1] * rs;
#pragma unroll
                    for (int e = 0; e < 4; ++e) { a0[e] *= sigm(b0[e]); a1[e] *= sigm(b1[e]); }
                    *(u32x4*)(U + (size_t)row * 512 + pn * 128 + cl) = pack8(a0, a1);
                    if (hasout) {
                        float* dst = nullptr;
                        if (!smp) { const int t = row & 8191; if (t >= 8162) dst = out + O_CONVP + (size_t)((row >> 13) * 30 + (t - 8162)) * 512; }
                        else if (row < MR) { const int si = row - MP; dst = out + O_CONVS + (size_t)((si >> 2) * 30 + 26 + (si & 3)) * 512; }
                        if (dst) { *(f32x4*)(dst + pn * 128 + cl) = a0; *(f32x4*)(dst + pn * 128 + cl + 4) = a1; }
                    }
                }
        } else if (pn < 7) {
            const int g = pn - 4;
#pragma unroll
            for (int ai = 0; ai < 2; ++ai)
#pragma unroll
                for (int m = 0; m < 4; ++m) {
                    const int row = rbase + ai * HALF + m * 16; const float rs = rstd[row] * C2;
#pragma unroll
                    for (int bj = 0; bj < 2; ++bj) *(u32x4*)(Q + (size_t)row * 768 + g * 256 + bj * HALF + cl) = pack8(acc[ai][bj][m][0] * rs, acc[ai][bj][m][1] * rs);
                }
        } else if (pn < 13) {
            const bool isV = pn >= 10; const int g = isV ? pn - 10 : pn - 7, sh = 2 * g, W = 128 << sh;
            bf16_t* base = isV ? Vb : Kb;
            const size_t offp = (g == 0 ? O_KV0P : g == 1 ? O_KV1P : O_KV2P) + (isV ? 256 : 0), offs = (g == 0 ? O_KV0S : g == 1 ? O_KV1S : O_KV2S) + (isV ? 256 : 0);
            const bool hasout = smp || (tb * 256 + 256 > 8192 - W);
#pragma unroll
            for (int ai = 0; ai < 2; ++ai)
#pragma unroll
                for (int m = 0; m < 4; ++m) {
                    const int row = rbase + ai * HALF + m * 16; const float rs = rstd[row];
                    int prow = row; float* dst = nullptr;
                    if (!smp) { const int t = row & 8191; prow = (row & ~8191) + ((t & ((1 << sh) - 1)) << (13 - sh)) + (t >> sh);
                        if (hasout && t >= 8192 - W) dst = out + offp + (size_t)((row >> 13) * W + (t - (8192 - W))) * 512; }
                    else if (row < MR) { const int si = row - MP; dst = out + offs + (size_t)((si >> 2) * W + (W - 4) + (si & 3)) * 512; }
#pragma unroll
                    for (int bj = 0; bj < 2; ++bj) { const f32x4 v0 = acc[ai][bj][m][0] * rs, v1 = acc[ai][bj][m][1] * rs;
                        *(u32x4*)(base + (size_t)prow * 768 + g * 256 + bj * HALF + cl) = pack8(v0, v1);
                        if (dst) { *(f32x4*)(dst + bj * HALF + cl) = v0; *(f32x4*)(dst + bj * HALF + cl + 4) = v1; } }
                }
        } else {
            const int gc0 = (pn - 13) * 256;
#pragma unroll
            for (int ai = 0; ai < 2; ++ai)
#pragma unroll
                for (int m = 0; m < 4; ++m) {
                    const int row = rbase + ai * HALF + m * 16; const float rs = rstd[row];
#pragma unroll
                    for (int bj = 0; bj < 2; ++bj) { f32x4 v0 = acc[ai][bj][m][0] * rs, v1 = acc[ai][bj][m][1] * rs;
#pragma unroll
                        for (int e = 0; e < 4; ++e) { v0[e] = sigm(v0[e]); v1[e] = sigm(v1[e]); }
                        *(u32x4*)(GT + (size_t)row * 2048 + gc0 + bj * HALF + cl) = pack8(v0, v1); }
                }
        }
    }
};
struct EpiGate {
    static constexpr bool PERM = true, AFTER_DRAIN = false;
    const bf16_t* GT; int goff; bf16_t* O;
    __device__ __forceinline__ void operator()(const f32x4 (&acc)[2][2][4][2], const Unit& u, int wr, int wc, int fr, int fq) const {
        const int rbase = u.pm * BM + wr * 64 + fr, cb = u.pn * BM + wc * 32 + 8 * fq;
#pragma unroll
        for (int ai = 0; ai < 2; ++ai)
#pragma unroll
            for (int m = 0; m < 4; ++m) { const int row = rbase + ai * HALF + m * 16;
#pragma unroll
                for (int bj = 0; bj < 2; ++bj) { const int col = cb + bj * HALF; f32x4 v0 = acc[ai][bj][m][0], v1 = acc[ai][bj][m][1];
                    if (GT) { f32x4 g0, g1; unpack8(*(const u32x4*)(GT + (size_t)row * 2048 + goff + col), g0, g1); v0 = v0 * g0; v1 = v1 * g1; }
                    *(u32x4*)(O + (size_t)row * 1024 + col) = pack8(v0, v1); } }
    }
};
struct EpiGateAdd {
    static constexpr bool PERM = true, AFTER_DRAIN = false;
    const bf16_t* GT; int goff; bf16_t* O;
    __device__ __forceinline__ void operator()(const f32x4 (&acc)[2][2][4][2], const Unit& u, int wr, int wc, int fr, int fq) const {
        const int rbase = u.pm * BM + wr * 64 + fr, cb = u.pn * BM + wc * 32 + 8 * fq;
#pragma unroll
        for (int ai = 0; ai < 2; ++ai)
#pragma unroll
            for (int m = 0; m < 4; ++m) { const int row = rbase + ai * HALF + m * 16;
#pragma unroll
                for (int bj = 0; bj < 2; ++bj) { const int col = cb + bj * HALF; f32x4 g0, g1, t0, t1;
                    unpack8(*(const u32x4*)(GT + (size_t)row * 2048 + goff + col), g0, g1); unpack8(*(const u32x4*)(O + (size_t)row * 1024 + col), t0, t1);
                    *(u32x4*)(O + (size_t)row * 1024 + col) = pack8(t0 + acc[ai][bj][m][0] * g0, t1 + acc[ai][bj][m][1] * g1); } }
    }
};
struct EpiResid {
    static constexpr bool PERM = true, AFTER_DRAIN = false;
    const float* xp; const float* xs; float* out; bf16_t* XB; float* ssq;
    __device__ __forceinline__ void operator()(const f32x4 (&acc)[2][2][4][2], const Unit& u, int wr, int wc, int fr, int fq) const {
        using namespace cfg;
        const int rbase = u.pm * BM + wr * 64 + fr, cb = u.pn * BM + wc * 32 + 8 * fq;
#pragma unroll
        for (int ai = 0; ai < 2; ++ai)
#pragma unroll
            for (int m = 0; m < 4; ++m) { const int row = rbase + ai * HALF + m * 16; const bool valid = row < MR;
                const float* src = row < MP ? xp + (size_t)row * 1024 : xs + (size_t)(row - MP) * 1024; float* dst = out + (size_t)row * 1024; float q = 0.f;
#pragma unroll
                for (int bj = 0; bj < 2; ++bj) { const int col = cb + bj * HALF; f32x4 x0 = (f32x4){0.f, 0.f, 0.f, 0.f}, x1 = x0;
                    if (valid) { x0 = *(const f32x4*)(src + col); x1 = *(const f32x4*)(src + col + 4); }
                    x0 = x0 + acc[ai][bj][m][0]; x1 = x1 + acc[ai][bj][m][1];
                    if (valid) { *(f32x4*)(dst + col) = x0; *(f32x4*)(dst + col + 4) = x1; }
                    *(u32x4*)(XB + (size_t)row * 1024 + col) = pack8(x0, x1); q += dot4(x0) + dot4(x1); }
                q += __shfl_xor(q, 16); q += __shfl_xor(q, 32);
                if (fq == 0) ssq[(size_t)row * 16 + u.pn * 4 + wc] = q; }
    }
};
struct EpiUp {
    static constexpr bool PERM = true, AFTER_DRAIN = false;
    const float* ssq; bf16_t* H;
    __device__ __forceinline__ void operator()(const f32x4 (&acc)[2][2][4][2], const Unit& u, int wr, int wc, int fr, int fq) const {
        const int rbase = u.pm * BM + wr * 64 + fr, cl = u.pn * HALF + wc * 32 + 8 * fq;
#pragma unroll
        for (int ai = 0; ai < 2; ++ai)
#pragma unroll
            for (int m = 0; m < 4; ++m) { const int row = rbase + ai * HALF + m * 16; const float rs = rstd16(ssq + (size_t)row * 16);
                f32x4 g0 = acc[ai][0][m][0] * rs, g1 = acc[ai][0][m][1] * rs; const f32x4 u0 = acc[ai][1][m][0] * rs, u1 = acc[ai][1][m][1] * rs;
#pragma unroll
                for (int e = 0; e < 4; ++e) { g0[e] = g0[e] * sigm(g0[e]) * u0[e]; g1[e] = g1[e] * sigm(g1[e]) * u1[e]; }
                *(u32x4*)(H + (size_t)row * cfg::DFF + cl) = pack8(g0, g1); }
    }
};
struct EpiPle {
    static constexpr bool PERM = true, AFTER_DRAIN = false;
    const float* ssq2; const bf16_t* PP; float* out; float* ssq3;
    __device__ __forceinline__ void operator()(const f32x4 (&acc)[2][2][4][2], const Unit& u, int wr, int wc, int fr, int fq) const {
        using namespace cfg;
        const int rbase = u.pm * BM + wr * 64 + fr, cb = u.pn * BM + wc * 32 + 8 * fq;
#pragma unroll
        for (int ai = 0; ai < 2; ++ai)
#pragma unroll
            for (int m = 0; m < 4; ++m) { const int row = rbase + ai * HALF + m * 16; const bool valid = row < MR; const float rs = rstd16(ssq2 + (size_t)row * 16);
                float* dst = out + (size_t)row * 1024; float q = 0.f;
#pragma unroll
                for (int bj = 0; bj < 2; ++bj) { const int col = cb + bj * HALF; f32x4 x0 = (f32x4){0.f, 0.f, 0.f, 0.f}, x1 = x0, p0, p1;
                    unpack8(*(const u32x4*)(PP + (size_t)row * 1024 + col), p0, p1);
                    if (valid) { x0 = *(const f32x4*)(dst + col); x1 = *(const f32x4*)(dst + col + 4); }
                    const f32x4 s0 = acc[ai][bj][m][0] * rs, s1 = acc[ai][bj][m][1] * rs;
#pragma unroll
                    for (int e = 0; e < 4; ++e) { x0[e] += sigm(s0[e]) * p0[e]; x1[e] += sigm(s1[e]) * p1[e]; }
                    if (valid) { *(f32x4*)(dst + col) = x0; *(f32x4*)(dst + col + 4) = x1; }
                    q += dot4(x0) + dot4(x1);
                    asm volatile("" ::: "memory"); }
                q += __shfl_xor(q, 16); q += __shfl_xor(q, 32);
                if (fq == 0) ssq3[(size_t)row * 16 + u.pn * 4 + wc] = q; }
    }
};

template <class Epi, class Sched, bool ALIGN_EPI = false, bool SP2 = false>
__device__ __forceinline__ void gemm_phase(PG8_LAS unsigned char* lds, const Gemm g, const Sched& S, const Epi& E) {
    int tid_ = threadIdx.x; asm volatile("" : "+v"(tid_));
    const int tid = tid_, wid = __builtin_amdgcn_readfirstlane(tid >> 6), lane = tid & 63, wr = wid >> 2, wc = wid & 3, fr = lane & 15, fq = lane >> 4;
    const int K = g.K, nt = K / BK;
    unsigned voffA[2], voffB[2];
#pragma unroll
    for (int i = 0; i < 2; ++i) { int R, C; stage_rc(tid * 16 + i * 8192, R, C); const int Rb = Epi::PERM ? ((R & ~31) + perm32(R & 31)) : R;
        voffA[i] = (unsigned)(R * K + C) * 2u; voffB[i] = (unsigned)(Rb * K + C) * 2u; }
    const size_t kstep = (size_t)(BK * 2);
    const size_t hstep = (size_t)HALF * K * 2;
    const size_t tstep = 2 * hstep;
    const unsigned ldsw = (unsigned)wid * 1024u;
    const int aoff = lds_byte(wr * 64 + fr, fq * 8), boff = lds_byte(wc * 32 + fr, fq * 8);
#define PG8_SA(b, h) (((b) * 2 + (h)) * HTB)
#define PG8_SB(b, h) ((4 + (b) * 2 + (h)) * HTB)
#define PG8_STAGE(bufoff, gbase, voff) do { _Pragma("unroll") for (int _i = 0; _i < 2; ++_i) \
        __builtin_amdgcn_global_load_lds((const unsigned*)((const char*)(gbase) + (voff)[_i]), (PG8_LAS unsigned*)(lds + (bufoff) + ldsw + _i * 8192), 16, 0, 0); } while (0)
#define PG8_LDA(dst, b, h) do { _Pragma("unroll") for (int m = 0; m < 4; ++m) _Pragma("unroll") for (int k = 0; k < 2; ++k) dst[m][k] = *(const PG8_LAS bf16x8*)(lds + PG8_SA(b, h) + aoff + m * 2048 + k * 1024); } while (0)
#define PG8_LDB(dst, b, h) do { _Pragma("unroll") for (int n = 0; n < 2; ++n) _Pragma("unroll") for (int k = 0; k < 2; ++k) dst[n][k] = *(const PG8_LAS bf16x8*)(lds + PG8_SB(b, h) + boff + n * 2048 + k * 1024); } while (0)
#define PG8_MMA(ai, bj, At, Bt) do { __builtin_amdgcn_s_setprio(1); _Pragma("unroll") for (int m = 0; m < 4; ++m) _Pragma("unroll") for (int n = 0; n < 2; ++n) _Pragma("unroll") for (int k = 0; k < 2; ++k) \
        acc[ai][bj][m][n] = __builtin_amdgcn_mfma_f32_16x16x32_bf16(Bt[n][k], At[m][k], acc[ai][bj][m][n], 0, 0, 0); __builtin_amdgcn_s_setprio(0); } while (0)
#define PG8_WAIT_V(n) asm volatile("s_waitcnt vmcnt(" #n ")" ::: "memory")
#define PG8_WAIT_L(n) asm volatile("s_waitcnt lgkmcnt(" #n ")" ::: "memory")
#define PG8_BAR __builtin_amdgcn_s_barrier()
#define PG8_SCHED __builtin_amdgcn_sched_barrier(0)
    Unit cur, nxt; int ui = 0;
    if (!S.next(0, cur)) return;
    f32x4 acc[2][2][4][2];
#pragma unroll
    for (int a = 0; a < 2; ++a)
#pragma unroll
        for (int b = 0; b < 2; ++b)
#pragma unroll
            for (int m = 0; m < 4; ++m)
#pragma unroll
                for (int n = 0; n < 2; ++n) acc[a][b][m][n] = (f32x4){0.f, 0.f, 0.f, 0.f};
    bf16x8 At[4][2], B0[2][2], B1[2][2];
    const char* cA = (const char*)g.A + (size_t)cur.pm * tstep; const char* cB = (const char*)g.Bt + (size_t)cur.pn * tstep;
    S.a_ready(cur);
    if constexpr (SP2) {
        PG8_STAGE(PG8_SB(0, 0), cB, voffB); PG8_STAGE(PG8_SB(0, 1), cB + hstep, voffB); PG8_STAGE(PG8_SA(0, 0), cA, voffA); PG8_STAGE(PG8_SA(0, 1), cA + hstep, voffA);
        if (wr == 1) PG8_BAR;
        PG8_WAIT_V(2); PG8_BAR;
        PG8_STAGE(PG8_SB(1, 0), cB + kstep, voffB); PG8_STAGE(PG8_SA(1, 0), cA + kstep, voffA); PG8_STAGE(PG8_SB(1, 1), cB + hstep + kstep, voffB);
        PG8_WAIT_V(6); PG8_BAR;
    } else {
        PG8_STAGE(PG8_SB(0, 0), cB, voffB); PG8_STAGE(PG8_SA(0, 0), cA, voffA); PG8_STAGE(PG8_SB(0, 1), cB + hstep, voffB); PG8_STAGE(PG8_SA(0, 1), cA + hstep, voffA);
        if (wr == 1) PG8_BAR;
        PG8_WAIT_V(4); PG8_BAR;
        PG8_STAGE(PG8_SB(1, 0), cB + kstep, voffB); PG8_STAGE(PG8_SA(1, 0), cA + kstep, voffA); PG8_STAGE(PG8_SB(1, 1), cB + hstep + kstep, voffB);
        PG8_WAIT_V(6); PG8_BAR;
    }
    for (;;) {
        const bool has_next = S.next(ui + 1, nxt);
        const char* nA = has_next ? (const char*)g.A + (size_t)nxt.pm * tstep : cA; const char* nB = has_next ? (const char*)g.Bt + (size_t)nxt.pn * tstep : cB;
        for (int t = 0; t < nt; t += 2) {
            const bool last = (t == nt - 2);
            const char* a1 = cA + (size_t)(t + 1) * kstep;
            const char* a2 = last ? nA : cA + (size_t)(t + 2) * kstep; const char* b2 = last ? nB : cB + (size_t)(t + 2) * kstep;
            const char* a3 = a2 + kstep; const char* b3 = b2 + kstep;
            if (last && has_next) S.a_ready(nxt);
            if constexpr (SP2) {
            PG8_LDB(B0, 0, 0); PG8_LDB(B1, 0, 1); PG8_SCHED; PG8_LDA(At, 0, 0); PG8_STAGE(PG8_SA(1, 1), a1 + hstep, voffA);
            PG8_WAIT_V(8); PG8_WAIT_L(0); PG8_BAR; PG8_MMA(0, 0, At, B0); PG8_MMA(0, 1, At, B1); PG8_BAR; PG8_SCHED;
            PG8_LDA(At, 0, 1); PG8_STAGE(PG8_SB(0, 0), b2, voffB); PG8_STAGE(PG8_SB(0, 1), b2 + hstep, voffB); PG8_STAGE(PG8_SA(0, 0), a2, voffA);
            PG8_WAIT_V(8); PG8_WAIT_L(0); PG8_BAR; PG8_MMA(1, 0, At, B0); PG8_MMA(1, 1, At, B1); PG8_BAR; PG8_SCHED;
            PG8_LDB(B0, 1, 0); PG8_LDB(B1, 1, 1); PG8_SCHED; PG8_LDA(At, 1, 0); PG8_STAGE(PG8_SA(0, 1), a2 + hstep, voffA);
            PG8_WAIT_V(8); PG8_WAIT_L(0); PG8_BAR; PG8_MMA(0, 0, At, B0); PG8_MMA(0, 1, At, B1); PG8_BAR; PG8_SCHED;
            PG8_LDA(At, 1, 1); PG8_STAGE(PG8_SB(1, 0), b3, voffB); PG8_STAGE(PG8_SB(1, 1), b3 + hstep, voffB); PG8_STAGE(PG8_SA(1, 0), a3, voffA);
            PG8_WAIT_V(8); PG8_WAIT_L(0); PG8_BAR; PG8_MMA(1, 0, At, B0); PG8_MMA(1, 1, At, B1); PG8_BAR; PG8_SCHED;
            } else {
            PG8_LDB(B0, 0, 0); PG8_SCHED; PG8_LDA(At, 0, 0); PG8_STAGE(PG8_SA(1, 1), a1 + hstep, voffA);
            PG8_WAIT_L(8); PG8_BAR; PG8_WAIT_L(0); PG8_MMA(0, 0, At, B0); PG8_BAR; PG8_SCHED;
            PG8_LDB(B1, 0, 1); PG8_STAGE(PG8_SB(0, 0), b2, voffB);
            PG8_BAR; PG8_WAIT_L(0); PG8_MMA(0, 1, At, B1); PG8_BAR;
            PG8_LDA(At, 0, 1); PG8_STAGE(PG8_SA(0, 0), a2, voffA);
            PG8_BAR; PG8_WAIT_L(0); PG8_MMA(1, 0, At, B0); PG8_BAR; PG8_SCHED;
            PG8_STAGE(PG8_SB(0, 1), b2 + hstep, voffB);
            PG8_WAIT_V(6); PG8_BAR; PG8_MMA(1, 1, At, B1); PG8_BAR;
            PG8_LDB(B0, 1, 0); PG8_SCHED; PG8_LDA(At, 1, 0); PG8_STAGE(PG8_SA(0, 1), a2 + hstep, voffA);
            PG8_WAIT_L(8); PG8_BAR; PG8_WAIT_L(0); PG8_MMA(0, 0, At, B0); PG8_BAR; PG8_SCHED;
            PG8_LDB(B1, 1, 1); PG8_STAGE(PG8_SB(1, 0), b3, voffB);
            PG8_BAR; PG8_WAIT_L(0); PG8_MMA(0, 1, At, B1); PG8_BAR;
            PG8_LDA(At, 1, 1); PG8_STAGE(PG8_SA(1, 0), a3, voffA);
            PG8_BAR; PG8_WAIT_L(0); PG8_MMA(1, 0, At, B0); PG8_BAR; PG8_SCHED;
            PG8_STAGE(PG8_SB(1, 1), b3 + hstep, voffB);
            PG8_WAIT_V(6); PG8_BAR; PG8_MMA(1, 1, At, B1); PG8_BAR;
            }
        }
        if constexpr (ALIGN_EPI) { if (wr == 0) PG8_BAR; }
        if constexpr (!Epi::AFTER_DRAIN) { E(acc, cur, wr, wc, fr, fq); S.done(cur); }
        if (!has_next) break;
#pragma unroll
        for (int a = 0; a < 2; ++a)
#pragma unroll
            for (int b = 0; b < 2; ++b)
#pragma unroll
                for (int m = 0; m < 4; ++m)
#pragma unroll
                    for (int n = 0; n < 2; ++n) acc[a][b][m][n] = (f32x4){0.f, 0.f, 0.f, 0.f};
        cur = nxt; cA = nA; cB = nB; ++ui;
        if constexpr (ALIGN_EPI) { if (wr == 1) PG8_BAR; }
    }
    PG8_WAIT_V(0);
    if constexpr (!ALIGN_EPI) { if (wr == 0) PG8_BAR; }
    PG8_BAR;
    if constexpr (Epi::AFTER_DRAIN) { E.fused(acc, cur, wr, wc, fr, fq, lds, wid, lane); S.done(cur); }
#undef PG8_SA
#undef PG8_SB
#undef PG8_STAGE
#undef PG8_LDA
#undef PG8_LDB
#undef PG8_MMA
#undef PG8_WAIT_V
#undef PG8_WAIT_L
#undef PG8_BAR
#undef PG8_SCHED
}
}
#define GAS __attribute__((address_space(1)))
#define LAS __attribute__((address_space(3)))
typedef unsigned short bf16;
typedef unsigned v4u __attribute__((ext_vector_type(4)));
typedef float f32x4 __attribute__((ext_vector_type(4)));
typedef short bf16x8 __attribute__((ext_vector_type(8)));
typedef GAS unsigned gu32;
typedef GAS unsigned long long gu64;
#define RLX_AGENT __ATOMIC_RELAXED, __HIP_MEMORY_SCOPE_AGENT
#define LDS_WAIT() asm volatile("s_waitcnt lgkmcnt(0)" ::: "memory")
#define VM_WAIT() asm volatile("s_waitcnt vmcnt(0)" ::: "memory")
__device__ __forceinline__ unsigned long long rt() { return __builtin_amdgcn_s_memrealtime(); }
__device__ __forceinline__ unsigned f2bf(float f) { unsigned u = __builtin_bit_cast(unsigned, f); return (u + 0x7fffu + ((u >> 16) & 1u)) >> 16; }
__device__ __forceinline__ unsigned pk2(float lo, float hi) { return f2bf(lo) | (f2bf(hi) << 16); }
#define XB_TMO      128
#define XB_XCNT(j)  (256  + 64 * (j))
#define XB_XSUB(j)  (1280 + 64 * (j))
#define XB_XGEN(j)  (2304 + 64 * (j))
#define XB_TOP      3328
#define XB_TOPGEN   3392
#define XCD_BAR_WORDS 3456
#define XB_SPIN_CAP (1u << 18)

__device__ __forceinline__ unsigned xb_ld(unsigned* p)              { return __hip_atomic_load(p, __ATOMIC_RELAXED, __HIP_MEMORY_SCOPE_AGENT); }
__device__ __forceinline__ unsigned xb_add(unsigned* p, unsigned v) { return __hip_atomic_fetch_add(p, v, __ATOMIC_RELAXED, __HIP_MEMORY_SCOPE_AGENT); }
__device__ __forceinline__ unsigned xb_xcc_id() { return (unsigned)__builtin_amdgcn_s_getreg((3 << 11) | 20) & 0xFu; }
#define XB_SPIN(cond, bar) do { unsigned _sp = 0; while (cond) { __builtin_amdgcn_s_sleep(1); \
    if ((++_sp & 255u) == 0u) { if (xb_ld(&(bar)[XB_TMO])) break; if (_sp > XB_SPIN_CAP) { atomicAdd(&(bar)[XB_TMO], 1u); break; } } } } while (0)

struct XcdBarrier {
    unsigned* bar; unsigned x;
    volatile LAS unsigned* st;
};

__device__ __forceinline__ XcdBarrier xcd_barrier_post(unsigned* bar, volatile LAS unsigned* st) {
    XcdBarrier b; b.bar = bar; b.x = xb_xcc_id(); b.st = st;
    if (threadIdx.x == 0) (void)xb_add(&bar[XB_XCNT(b.x)], 1u);
    return b;
}
__device__ __forceinline__ void xcd_barrier_complete(unsigned* bar, unsigned x, unsigned& nloc, unsigned& nx) {
    const unsigned G = gridDim.x * gridDim.y * gridDim.z;
    unsigned sum, cnt, mine, sp = 0u;
    for (;;) {
        sum = 0u; cnt = 0u; mine = 0u;
#pragma unroll
        for (unsigned j = 0; j < 16; ++j) { const unsigned c = xb_ld(&bar[XB_XCNT(j)]); sum += c; cnt += (c > 0u) ? 1u : 0u; mine = (j == x) ? c : mine; }
        if (sum == G) break;
        __builtin_amdgcn_s_sleep(1);
        if ((++sp & 255u) == 0u) { if (xb_ld(&bar[XB_TMO])) break; if (sp > XB_SPIN_CAP) { atomicAdd(&bar[XB_TMO], 1u); break; } }
    }
    nloc = mine > 0u ? mine : 1u; nx = cnt > 0u ? cnt : 1u;
}

__device__ __forceinline__ void xcd_barrier(const XcdBarrier& b) {
    asm volatile("s_waitcnt vmcnt(0)" ::: "memory");
    __syncthreads();
    if (threadIdx.x == 0) {
        unsigned* bar = b.bar;
        __builtin_amdgcn_s_waitcnt(0);
        unsigned nloc = b.st[0], nx = b.st[1];
        if (nloc == 0u) { xcd_barrier_complete(bar, b.x, nloc, nx); b.st[0] = nloc; b.st[1] = nx; }
        const unsigned old = xb_add(&bar[XB_XSUB(b.x)], 1u);
        const unsigned gen = old / nloc;
        if (old + 1u == (gen + 1u) * nloc) {
            __builtin_amdgcn_fence(__ATOMIC_RELEASE, "agent");
            asm volatile("s_waitcnt vmcnt(0)" ::: "memory");
            const unsigned og = xb_add(&bar[XB_TOP], 1u);
            const unsigned tg = og / nx;
            if (og + 1u == (tg + 1u) * nx) xb_add(&bar[XB_TOPGEN], 1u);
            else XB_SPIN(xb_ld(&bar[XB_TOPGEN]) == tg, bar);
            __builtin_amdgcn_fence(__ATOMIC_ACQUIRE, "agent");
            xb_add(&bar[XB_XGEN(b.x)], 1u);
            asm volatile("s_waitcnt vmcnt(0)" ::: "memory");
        } else {
            XB_SPIN(xb_ld(&bar[XB_XGEN(b.x)]) == gen, bar);
            __builtin_amdgcn_fence(__ATOMIC_ACQUIRE, "agent");
            asm volatile("s_waitcnt vmcnt(0)" ::: "memory");
        }
    }
    __syncthreads();
}

using namespace cfg;
constexpr int NWAVES = 8, NTHREADS = 512;
#ifndef MK_N_LAUNCHES
#define MK_N_LAUNCHES 1
#endif
constexpr int NPHASE = 9;
constexpr int N_LAUNCHES = MK_N_LAUNCHES;

constexpr size_t MiB = 1u << 20;
constexpr size_t WS_CTL = 0, CTL_ZERO_BYTES = 64 * 1024;
constexpr size_t WS_RSTD0 = 1 * MiB, WS_SSQ1 = 2 * MiB, WS_SSQ2 = 5 * MiB, WS_SSQ3 = 8 * MiB;
constexpr size_t WS_W_IN = 12 * MiB, WS_W_C = 23 * MiB, WS_W_A = 24 * MiB, WS_W_O = 25 * MiB, WS_W_UP = 27 * MiB, WS_W_DN = 38 * MiB, WS_W_PG = 44 * MiB, WS_W_PL = 46 * MiB;
constexpr size_t WS_PB = 48 * MiB;
constexpr size_t WS_XB = 66 * MiB;
constexpr size_t WS_CB = WS_XB, WS_OB = WS_XB + 34 * MiB;
constexpr size_t WS_R1 = 132 * MiB;
constexpr size_t WS_U = WS_R1, WS_Q = WS_R1 + 33 * MiB, WS_K = WS_R1 + 82 * MiB, WS_V = WS_R1 + 131 * MiB;
constexpr size_t WS_MIX = WS_R1, WS_H = WS_R1;
constexpr size_t WS_GT = 316 * MiB;
constexpr size_t WS_PP = WS_GT;
constexpr size_t WS_END = 446 * MiB;
static_assert(WS_V + (size_t)MPAD * 768 * 2 <= WS_GT && WS_H + (size_t)MPAD * DFF * 2 <= WS_GT && WS_GT + (size_t)MPAD * 2048 * 2 <= WS_END, "ws map");
static_assert(WS_OB + (size_t)MPAD * 256 * 2 <= WS_R1 && WS_CB + (size_t)MPAD * 512 * 2 <= WS_OB && WS_PB + (size_t)MPAD * 256 * 2 <= WS_XB, "ws map 2");
static_assert(WS_W_IN + (size_t)NIN * 1024 * 2 <= WS_W_C && WS_W_UP + (size_t)2 * DFF * 1024 * 2 <= WS_W_DN && WS_W_DN + (size_t)DFF * 1024 * 2 <= WS_W_PG && WS_SSQ1 + (size_t)MPAD * 64 <= WS_SSQ2, "ws map 3");
constexpr int CW_BAR = 1024;

constexpr int RING_BYTES = 131072, LDSCTL_OFF = RING_BYTES, MISC_OFF = LDSCTL_OFF + 320, LDS_BYTES = 147456;

struct Args { const float* in[25]; float* out; unsigned char* ws; int ph_lo, ph_hi; };

__device__ __forceinline__ float wave_sum(float v) {
#pragma unroll
    for (int o = 1; o < 64; o <<= 1) v += __shfl_xor(v, o);
    return v;
}
__device__ __forceinline__ float wave_max(float v) {
#pragma unroll
    for (int o = 1; o < 64; o <<= 1) v = fmaxf(v, __shfl_xor(v, o));
    return v;
}
__device__ __forceinline__ float bflo(unsigned w) { return __uint_as_float(w << 16); }
__device__ __forceinline__ float bfhi(unsigned w) { return __uint_as_float(w & 0xffff0000u); }
__device__ __forceinline__ float fsig(float x) { return __builtin_amdgcn_rcpf(1.0f + __builtin_amdgcn_exp2f(-1.4426950408889634f * x)); }

__device__ __forceinline__ void p0_transpose_item(const float* W, int ldw, int k0, int n0, bf16* WT, int ldt, int row0, const float* gk, LAS float* scr, int lane) {
#pragma unroll 8
    for (int i = 0; i < 32; ++i) { const int kk = 2 * i + (lane >> 5); float v = W[(size_t)(k0 + kk) * ldw + n0 + (lane & 31)]; if (gk) v *= gk[k0 + kk]; scr[kk * 33 + (lane & 31)] = v; }
    LDS_WAIT(); asm volatile("" ::: "memory");
    const int c = lane & 7;
#pragma unroll
    for (int j = 0; j < 4; ++j) { const int n = (lane >> 3) + 8 * j; const LAS float* s = scr + (8 * c) * 33 + n;
        v4u o; o.x = pk2(s[0 * 33], s[1 * 33]); o.y = pk2(s[2 * 33], s[3 * 33]); o.z = pk2(s[4 * 33], s[5 * 33]); o.w = pk2(s[6 * 33], s[7 * 33]);
        *(GAS v4u*)(WT + (size_t)(row0 + n) * ldt + k0 + 8 * c) = o; }
    LDS_WAIT(); asm volatile("" ::: "memory");
}
__device__ __forceinline__ void p0_mat_item(const float* W, int K, int ldw, int csrc0, int ncols, bf16* WT, int ldt, int row0, const float* gk, LAS float* scr, int it, int lane) {
    const int nblk = ncols / 32, kb = it / nblk, nb = it % nblk;
    p0_transpose_item(W, ldw, 64 * kb, csrc0 + 32 * nb, WT, ldt, row0 + 32 * nb, gk, scr, lane);
}

typedef float f32x16 __attribute__((ext_vector_type(16)));
typedef short v4i16_t __attribute__((ext_vector_type(4)));
__device__ __forceinline__ int crow(int r, int hi) { return (r & 3) + 8 * (r >> 2) + 4 * hi; }
constexpr int VPITCH = 144;
constexpr int ATT_WSF = 32 * VPITCH, ATT_OST = ATT_WSF + 256, ATT_WAVE_BYTES = 9216;
static_assert(ATT_OST + 4096 <= ATT_WAVE_BYTES && ATT_WAVE_BYTES * NWAVES <= RING_BYTES, "attention LDS");

struct AttState { float m, l; f32x16 o0, o1; };

template <int G>
__device__ __forceinline__ void att_group(AttState& st, const bf16* Q, const bf16* Kb, const bf16* Vb, int b, int slot, int sp, int r16, LAS unsigned char* wl, int lane) {
    constexpr int SH = 2 * G, D = 1 << SH, SQ = 16 >> SH, SG = 8192 >> SH;
    const int c = lane & 31, h = lane >> 5;
    const int rg = r16 & (D - 1), a = r16 >> SH, u0 = (512 >> SH) * sp + a, uq = u0 + SQ * c;
    const float slope2 = __builtin_amdgcn_exp2f(-8.0f * (float)(4 * G + slot + 1) / 12.0f) * (1.4426950408889634f * (float)D);
    const int colb = 256 * G + 64 * slot;
    const bf16* qp = Q + ((size_t)b * 8192 + 512 * sp + r16 + 16 * c) * 768 + colb + 8 * h;
    bf16x8 qf[4];
#pragma unroll
    for (int s = 0; s < 4; ++s) qf[s] = *(const bf16x8*)(qp + 16 * s);
    int n_lo = (u0 - 128) >> 5; if (n_lo < 0) n_lo = 0; const int n_hi = (u0 + 31 * SQ) >> 5;
    const size_t kvrow0 = (size_t)b * 8192 + (size_t)rg * SG;
    LAS float* wsf = (LAS float*)(wl + ATT_WSF);
    const LAS unsigned char* vtr0 = wl + (4 * h + ((lane & 15) >> 2)) * VPITCH + (16 * ((lane >> 4) & 1) + 4 * (lane & 3)) * 2;
    for (int n = n_lo; n <= n_hi; ++n) {
        const bf16* kp = Kb + (kvrow0 + 32 * n + c) * 768 + colb + 8 * h;
        bf16x8 kf[4];
#pragma unroll
        for (int s = 0; s < 4; ++s) kf[s] = *(const bf16x8*)(kp + 16 * s);
        const bf16* vp = Vb + (kvrow0 + 32 * n + (lane >> 1)) * 768 + colb + 32 * (lane & 1);
        v4u vv[4];
#pragma unroll
        for (int i = 0; i < 4; ++i) vv[i] = *(const v4u*)(vp + 8 * i);
        f32x16 s = {};
#pragma unroll
        for (int k = 0; k < 4; ++k) s = __builtin_amdgcn_mfma_f32_32x32x16_bf16(kf[k], qf[k], s, 0, 0, 0);
#pragma unroll
        for (int i = 0; i < 4; ++i) *(LAS v4u*)(wl + (lane >> 1) * VPITCH + (lane & 1) * 64 + 16 * i) = vv[i];
        asm volatile("" ::: "memory");
        const int dbase = uq - 32 * n - 4 * h;
        float mx = -INFINITY;
#pragma unroll
        for (int r = 0; r < 16; ++r) { const int dist = dbase - ((r & 3) + 8 * (r >> 2)); const bool valid = (unsigned)dist <= 128u;
            s[r] = valid ? s[r] - slope2 * (float)dist : -INFINITY; mx = fmaxf(mx, s[r]); }
        mx = fmaxf(mx, __shfl_xor(mx, 32));
        const float mnew = fmaxf(st.m, mx);
        if (__any(mnew > st.m)) {
            const float f = __builtin_amdgcn_exp2f(st.m - mnew);
            st.l *= f; st.m = mnew;
            if (h == 0) wsf[c] = f;
            asm volatile("" ::: "memory");
#pragma unroll
            for (int r = 0; r < 16; ++r) { const float fr_ = wsf[crow(r, h)]; st.o0[r] *= fr_; st.o1[r] *= fr_; }
            asm volatile("" ::: "memory");
        }
        float ps = 0.f;
#pragma unroll
        for (int r = 0; r < 16; ++r) { s[r] = __builtin_amdgcn_exp2f(s[r] - st.m); ps += s[r]; }
        st.l += ps;
        v4u pw0, pw1;
        pw0.x = pk2(s[0], s[1]); pw0.y = pk2(s[2], s[3]); pw0.z = pk2(s[4], s[5]); pw0.w = pk2(s[6], s[7]);
        pw1.x = pk2(s[8], s[9]); pw1.y = pk2(s[10], s[11]); pw1.z = pk2(s[12], s[13]); pw1.w = pk2(s[14], s[15]);
        const bf16x8 pa0 = __builtin_bit_cast(bf16x8, pw0), pa1 = __builtin_bit_cast(bf16x8, pw1);
#pragma unroll
        for (int nb = 0; nb < 2; ++nb)
#pragma unroll
            for (int ks = 0; ks < 2; ++ks) {
                const LAS unsigned char* p = vtr0 + (16 * ks) * VPITCH + 64 * nb;
                const v4i16_t lo = __builtin_amdgcn_ds_read_tr16_b64_v4i16((LAS v4i16_t*)p);
                const v4i16_t hi = __builtin_amdgcn_ds_read_tr16_b64_v4i16((LAS v4i16_t*)(p + 8 * VPITCH));
                const bf16x8 vf = (bf16x8){lo[0], lo[1], lo[2], lo[3], hi[0], hi[1], hi[2], hi[3]};
                if (nb == 0) st.o0 = __builtin_amdgcn_mfma_f32_32x32x16_bf16(ks == 0 ? pa0 : pa1, vf, st.o0, 0, 0, 0);
                else         st.o1 = __builtin_amdgcn_mfma_f32_32x32x16_bf16(ks == 0 ? pa0 : pa1, vf, st.o1, 0, 0, 0);
            }
        asm volatile("" ::: "memory");
    }
}
__device__ __forceinline__ void att_job(const bf16* Q, const bf16* Kb, const bf16* Vb, bf16* OB, int b, int slot, int sp, int r16, LAS unsigned char* wl, int lane) {
    AttState st; st.m = -1e30f; st.l = 0.f; st.o0 = (f32x16){}; st.o1 = (f32x16){};
    att_group<0>(st, Q, Kb, Vb, b, slot, sp, r16, wl, lane);
    att_group<1>(st, Q, Kb, Vb, b, slot, sp, r16, wl, lane);
    att_group<2>(st, Q, Kb, Vb, b, slot, sp, r16, wl, lane);
    const int c = lane & 31, h = lane >> 5;
    LAS float* wsf = (LAS float*)(wl + ATT_WSF);
    const float lt = st.l + __shfl_xor(st.l, 32);
    if (h == 0) wsf[c] = __builtin_amdgcn_rcpf(lt);
    asm volatile("" ::: "memory");
    LAS bf16* ost = (LAS bf16*)(wl + ATT_OST);
#pragma unroll
    for (int r = 0; r < 16; ++r) { const float inv = wsf[crow(r, h)]; const int q = crow(r, h);
        ost[q * 64 + c] = (bf16)f2bf(st.o0[r] * inv); ost[q * 64 + 32 + c] = (bf16)f2bf(st.o1[r] * inv); }
    asm volatile("" ::: "memory");
#pragma unroll
    for (int i = 0; i < 4; ++i) { const int row = i * 8 + (lane >> 3), ch = lane & 7;
        const v4u v = *(const LAS v4u*)(ost + row * 64 + ch * 8);
        *(v4u*)(OB + ((size_t)b * 8192 + 512 * sp + r16 + 16 * row) * 256 + 64 * slot + ch * 8) = v; }
    asm volatile("" ::: "memory");
}

constexpr int CONV_ROWS = 94, CONV_RED_OFF = 96512;
__device__ __forceinline__ void conv_tile(const bf16* U, bf16* CB, const float* w_dw, const float* b_dw, const float* ln_g, const float* ln_b, int b, int t0, LAS unsigned char* lds, int tid) {
    const int lane = tid & 63, wave = tid >> 6;
    LAS bf16* us = (LAS bf16*)lds;
    for (int j = wave; j < CONV_ROWS; j += NWAVES) { const int t = t0 - 30 + j; v4u v = (v4u){0u, 0u, 0u, 0u};
        if (t >= 0) v = *(const v4u*)(U + ((size_t)b * 8192 + t) * 512 + lane * 8);
        *(LAS v4u*)(us + j * 512 + lane * 8) = v; }
    __syncthreads();
    const int cp = tid & 255, th = tid >> 8;
    float w0[31], w1[31];
    const float* wp = w_dw + 2 * cp; asm volatile("" : "+v"(wp));
#pragma unroll
    for (int k = 0; k < 31; ++k) { const float2 w = *(const float2*)(wp + k * 512); w0[k] = w.x; w1[k] = w.y; }
    const float2 bias = *(const float2*)(b_dw + 2 * cp);
    const float2 g = *(const float2*)(ln_g + 2 * cp), be = *(const float2*)(ln_b + 2 * cp);
    LAS float* red = (LAS float*)(lds + CONV_RED_OFF);
    const int wq = wave & 3;
#pragma unroll 1
    for (int pass = 0; pass < 2; ++pass) {
        const int tb = th * 32 + pass * 16;
        float a0[16], a1[16];
#pragma unroll
        for (int i = 0; i < 16; ++i) { a0[i] = bias.x; a1[i] = bias.y; }
#pragma unroll
        for (int j = 0; j < 46; ++j) { const unsigned xv = *(const LAS unsigned*)(us + (tb + j) * 512 + 2 * cp); const float x0 = bflo(xv), x1 = bfhi(xv);
#pragma unroll
            for (int i = 0; i < 16; ++i) if (j - i >= 0 && j - i <= 30) { a0[i] += w0[j - i] * x0; a1[i] += w1[j - i] * x1; }
            if ((j & 7) == 7) asm volatile("" ::: "memory"); }
#pragma unroll
        for (int i = 0; i < 16; ++i) { const float s1 = wave_sum(a0[i] + a1[i]), s2 = wave_sum(a0[i] * a0[i] + a1[i] * a1[i]);
            if (lane == 0) { red[((th * 16 + i) * 4 + wq) * 2] = s1; red[((th * 16 + i) * 4 + wq) * 2 + 1] = s2; } }
        __syncthreads();
#pragma unroll
        for (int i = 0; i < 16; ++i) { const LAS float* r = red + (th * 16 + i) * 8;
            const float s1 = (r[0] + r[2]) + (r[4] + r[6]), s2 = (r[1] + r[3]) + (r[5] + r[7]);
            const float mean = s1 * (1.f / 512.f), var = s2 * (1.f / 512.f) - mean * mean, rstd = __builtin_amdgcn_rsqf(var + EPS);
            float y0 = (a0[i] - mean) * rstd * g.x + be.x, y1 = (a1[i] - mean) * rstd * g.y + be.y;
            y0 *= fsig(y0); y1 *= fsig(y1);
            *(unsigned*)(CB + ((size_t)b * 8192 + t0 + tb + i) * 512 + 2 * cp) = pk2(y0, y1); }
        __syncthreads();
    }
}
__device__ __forceinline__ void conv_sample(const bf16* U, bf16* CB, const float* state, const float* w_dw, const float* b_dw, const float* ln_g, const float* ln_b, int bs, LAS unsigned char* lds, int tid) {
    const int lane = tid & 63, wave = tid >> 6, ch = tid;
    float x[34];
#pragma unroll
    for (int j = 0; j < 30; ++j) x[j] = state[((size_t)bs * 30 + j) * 512 + ch];
#pragma unroll
    for (int j = 0; j < 4; ++j) x[30 + j] = __uint_as_float((unsigned)U[((size_t)MP + bs * 4 + j) * 512 + ch] << 16);
    float a[4]; const float bias = b_dw[ch];
#pragma unroll
    for (int i = 0; i < 4; ++i) a[i] = bias;
#pragma unroll
    for (int k = 0; k < 31; ++k) { const float w = w_dw[k * 512 + ch];
#pragma unroll
        for (int i = 0; i < 4; ++i) a[i] += w * x[i + k]; }
    LAS float* red = (LAS float*)lds;
#pragma unroll
    for (int i = 0; i < 4; ++i) { const float s1 = wave_sum(a[i]), s2 = wave_sum(a[i] * a[i]); if (lane == 0) { red[(i * 8 + wave) * 2] = s1; red[(i * 8 + wave) * 2 + 1] = s2; } }
    __syncthreads();
    const float g = ln_g[ch], be = ln_b[ch];
#pragma unroll
    for (int i = 0; i < 4; ++i) { float s1 = 0.f, s2 = 0.f;
#pragma unroll
        for (int w = 0; w < 8; ++w) { s1 += red[(i * 8 + w) * 2]; s2 += red[(i * 8 + w) * 2 + 1]; }
        const float mean = s1 * (1.f / 512.f), var = s2 * (1.f / 512.f) - mean * mean, rstd = __builtin_amdgcn_rsqf(var + EPS);
        float y = (a[i] - mean) * rstd * g + be; y *= fsig(y);
        CB[((size_t)MP + bs * 4 + i) * 512 + ch] = (bf16)f2bf(y); }
    __syncthreads();
}
__device__ __forceinline__ void att_sample(const bf16* Q, const bf16* Kb, const bf16* Vb, bf16* OB, const float* c0, const float* c1, const float* c2, int bs, int tok, int slot, LAS unsigned char* lds, int tid) {
    const int lane = tid & 63, wave = tid >> 6;
    LAS float* qs = (LAS float*)lds;
    LAS float* sc = qs + 192;
    LAS float* red = sc + 512;
    LAS float* part = red + 16;
    const size_t qrow = (size_t)MP + bs * 4 + tok;
    if (tid < 192) { const int g = tid >> 6, dd = tid & 63; qs[tid] = __uint_as_float((unsigned)Q[qrow * 768 + 256 * g + 64 * slot + dd] << 16); }
    __syncthreads();
    const int e = tid; float s = -INFINITY;
    int g = 0, j = 0;
    if (e < 387) { g = e / 129; j = e - g * 129; }
    const int sh = 2 * g, W = 128 << sh, idx = W + tok - (j << sh);
    const float* cg = (g == 0) ? c0 : (g == 1) ? c1 : c2;
    if (e < 387) {
        float d = 0.f; const LAS float* q = qs + 64 * g;
        if (idx >= W) { const bf16* kp = Kb + ((size_t)MP + bs * 4 + (idx - W)) * 768 + 256 * g + 64 * slot;
#pragma unroll
            for (int i = 0; i < 8; ++i) { const v4u w = *(const v4u*)(kp + 8 * i);
                d += q[8 * i] * bflo(w.x) + q[8 * i + 1] * bfhi(w.x) + q[8 * i + 2] * bflo(w.y) + q[8 * i + 3] * bfhi(w.y) + q[8 * i + 4] * bflo(w.z) + q[8 * i + 5] * bfhi(w.z) + q[8 * i + 6] * bflo(w.w) + q[8 * i + 7] * bfhi(w.w); } }
        else { const float* kp = cg + (((size_t)bs * W + idx) * 2 + 0) * 256 + slot * 64;
#pragma unroll
            for (int i = 0; i < 16; ++i) { const f32x4 w = *(const f32x4*)(kp + 4 * i); d += q[4 * i] * w[0] + q[4 * i + 1] * w[1] + q[4 * i + 2] * w[2] + q[4 * i + 3] * w[3]; } }
        const float slope2 = __builtin_amdgcn_exp2f(-8.0f * (float)(4 * g + slot + 1) / 12.0f) * 1.4426950408889634f;
        s = d - slope2 * (float)(j << sh);
    }
    float mx = wave_max(s); if (lane == 0) red[wave] = mx;
    __syncthreads();
    mx = red[0];
#pragma unroll
    for (int w = 1; w < 8; ++w) mx = fmaxf(mx, red[w]);
    const float p = __builtin_amdgcn_exp2f(s - mx);
    sc[tid] = p;
    const float ps = wave_sum(p); if (lane == 0) red[8 + wave] = ps;
    __syncthreads();
    float l = 0.f;
#pragma unroll
    for (int w = 0; w < 8; ++w) l += red[8 + w];
    float o = 0.f;
    for (int ee = wave; ee < 387; ee += 8) { const int g2 = ee / 129, j2 = ee - g2 * 129, sh2 = 2 * g2, W2 = 128 << sh2, idx2 = W2 + tok - (j2 << sh2);
        float v;
        if (idx2 >= W2) v = __uint_as_float((unsigned)Vb[((size_t)MP + bs * 4 + (idx2 - W2)) * 768 + 256 * g2 + 64 * slot + lane] << 16);
        else { const float* cgg = (g2 == 0) ? c0 : (g2 == 1) ? c1 : c2; v = cgg[(((size_t)bs * W2 + idx2) * 2 + 1) * 256 + slot * 64 + lane]; }
        o += sc[ee] * v; }
    part[wave * 64 + lane] = o;
    __syncthreads();
    if (wave == 0) { float t = 0.f;
#pragma unroll
        for (int w = 0; w < 8; ++w) t += part[w * 64 + lane];
        OB[qrow * 256 + 64 * slot + lane] = (bf16)f2bf(t * __builtin_amdgcn_rcpf(l)); }
    __syncthreads();
}

__global__ void __launch_bounds__(NTHREADS, 2) mega_fwd(Args args) {
    extern __shared__ __attribute__((aligned(16))) unsigned char lds_raw[];
    LAS unsigned char* lds = (LAS unsigned char*)lds_raw;
    volatile LAS unsigned* MISC = (volatile LAS unsigned*)(lds + MISC_OFF);
    const int tid = threadIdx.x, lane = tid & 63, wave = __builtin_amdgcn_readfirstlane(tid >> 6);
    const int G = gridDim.x; const int bx = blockIdx.x; const int vcu = (G % 8 == 0) ? (bx % 8) * (G / 8) + bx / 8 : bx;
    unsigned char* ws = args.ws; float* out = args.out;
    gu32* ctl = (gu32*)(ws + WS_CTL);
    const float* x_prompt = args.in[0]; const float* x_sample = args.in[1]; const float* state_conv = args.in[2];
    const float* cache0 = args.in[3]; const float* cache1 = args.in[4]; const float* cache2 = args.in[5];
    const float* p_prompt = args.in[6]; const float* p_sample = args.in[7];
    const float* g_mix = args.in[8]; const float* w_in = args.in[9]; const float* w_dw = args.in[10]; const float* b_dw = args.in[11];
    const float* ln_g = args.in[12]; const float* ln_b = args.in[13]; const float* w_conv_out = args.in[14]; const float* w_att_out = args.in[15];
    const float* w_out = args.in[16]; const float* g_ffn = args.in[17]; const float* w_ffn_gate = args.in[18]; const float* w_ffn_up = args.in[19];
    const float* w_ffn_down = args.in[20]; const float* g_ple = args.in[21]; const float* w_ple_gate = args.in[22]; const float* w_ple = args.in[23];
    const float* g_final = args.in[24];
    float* rstd0 = (float*)(ws + WS_RSTD0); float* ssq1 = (float*)(ws + WS_SSQ1); float* ssq2 = (float*)(ws + WS_SSQ2); float* ssq3 = (float*)(ws + WS_SSQ3);
    bf16* Wi_t = (bf16*)(ws + WS_W_IN); bf16* Wc_t = (bf16*)(ws + WS_W_C); bf16* Wa_t = (bf16*)(ws + WS_W_A); bf16* Wo_t = (bf16*)(ws + WS_W_O);
    bf16* Wu_t = (bf16*)(ws + WS_W_UP); bf16* Wd_t = (bf16*)(ws + WS_W_DN); bf16* Wg_t = (bf16*)(ws + WS_W_PG); bf16* Wp_t = (bf16*)(ws + WS_W_PL);
    bf16* PB = (bf16*)(ws + WS_PB); bf16* XB = (bf16*)(ws + WS_XB); bf16* CB = (bf16*)(ws + WS_CB); bf16* OB = (bf16*)(ws + WS_OB);
    bf16* U = (bf16*)(ws + WS_U); bf16* Qb = (bf16*)(ws + WS_Q); bf16* Kb = (bf16*)(ws + WS_K); bf16* Vb = (bf16*)(ws + WS_V);
    bf16* MIX = (bf16*)(ws + WS_MIX); bf16* HB = (bf16*)(ws + WS_H); bf16* GT = (bf16*)(ws + WS_GT); bf16* PP = (bf16*)(ws + WS_PP);

    for (int u = tid; u < (LDS_BYTES - LDSCTL_OFF) / 4; u += NTHREADS) ((LAS unsigned*)(lds + LDSCTL_OFF))[u] = 0u;
    __syncthreads();
    XcdBarrier bar; bar.bar = (unsigned*)(ctl + CW_BAR); bar.x = 0; bar.st = nullptr;
    if (N_LAUNCHES == 1) bar = xcd_barrier_post((unsigned*)(ctl + CW_BAR), MISC + 8);
#define GRID_BAR() do { if (N_LAUNCHES == 1) xcd_barrier(bar); } while (0)
    const int lo = args.ph_lo, hi = args.ph_hi;
#ifndef PH_MASK
#define PH_MASK 0x1ff
#endif
#define IN(k) ((((PH_MASK) >> (k)) & 1) && lo <= (k) && (k) < hi)
#define BOTH(k) (IN(k) && IN((k) + 1))
    const int gw = vcu * NWAVES + wave, NGW = G * NWAVES;

    if (IN(0)) {
        LAS float* scr = (LAS float*)(lds + wave * 16384);
        constexpr int I_IN = 16 * (NIN / 32), I_C = 8 * 32, I_A = 4 * 32, I_O = 16 * 32, I_U = 16 * (2 * DFF / 32), I_D = (DFF / 64) * 32, I_G = 16 * 32, I_P = 4 * 32;
        constexpr int NITEMS = I_IN + I_C + I_A + I_O + I_U + I_D + I_G + I_P;
        for (int it = gw; it < NITEMS; it += NGW) {
            int r = it;
            if (r < I_IN) {
                const int nblk = NIN / 32, kb = r / nblk, nb = r % nblk, R = 32 * nb, pn = R >> 8, cc = R & 255;
                const int csrc = pn < 4 ? (cc < 128 ? 128 * pn + cc : 512 + 128 * pn + (cc - 128)) : R;
                p0_transpose_item(w_in, NIN, 64 * kb, csrc, Wi_t, 1024, R, g_mix, scr, lane); continue; } r -= I_IN;
            if (r < I_C) { p0_mat_item(w_conv_out, 512, 1024, 0, 1024, Wc_t, 512, 0, nullptr, scr, r, lane); continue; } r -= I_C;
            if (r < I_A) { p0_mat_item(w_att_out, 256, 1024, 0, 1024, Wa_t, 256, 0, nullptr, scr, r, lane); continue; } r -= I_A;
            if (r < I_O) { p0_mat_item(w_out, 1024, 1024, 0, 1024, Wo_t, 1024, 0, nullptr, scr, r, lane); continue; } r -= I_O;
            if (r < I_U) {
                const int nblk = 2 * DFF / 32, kb = r / nblk, nb = r % nblk, R = 32 * nb, pn = R >> 8, cc = R & 255;
                const float* src = cc < 128 ? w_ffn_gate : w_ffn_up; const int csrc = 128 * pn + (cc & 127);
                p0_transpose_item(src, DFF, 64 * kb, csrc, Wu_t, 1024, R, g_ffn, scr, lane); continue; } r -= I_U;
            if (r < I_D) { p0_mat_item(w_ffn_down, DFF, 1024, 0, 1024, Wd_t, DFF, 0, nullptr, scr, r, lane); continue; } r -= I_D;
            if (r < I_G) { p0_mat_item(w_ple_gate, 1024, 1024, 0, 1024, Wg_t, 1024, 0, g_ple, scr, r, lane); continue; } r -= I_G;
            p0_mat_item(w_ple, 256, 1024, 0, 1024, Wp_t, 256, 0, nullptr, scr, r, lane);
        }
        for (int m = gw; m < MPAD; m += NGW) {
            GAS unsigned long long* xo = (GAS unsigned long long*)(XB + (size_t)m * 1024) + lane;
            GAS unsigned long long* po = (GAS unsigned long long*)(PB + (size_t)m * 256) + lane;
            if (m < MR) {
                const float* xr = m < MP ? x_prompt + (size_t)m * 1024 : x_sample + (size_t)(m - MP) * 1024;
                const float* pr = m < MP ? p_prompt + (size_t)m * 256 : p_sample + (size_t)(m - MP) * 256;
                f32x4 v[4]; float s = 0.f;
#pragma unroll
                for (int j = 0; j < 4; ++j) { v[j] = ((const GAS f32x4*)xr)[lane + 64 * j]; s += (v[j][0] * v[j][0] + v[j][1] * v[j][1]) + (v[j][2] * v[j][2] + v[j][3] * v[j][3]); }
                const f32x4 pv = ((const GAS f32x4*)pr)[lane];
                s = wave_sum(s);
                if (lane == 0) rstd0[m] = __builtin_amdgcn_rsqf(s * (1.f / 1024.f) + EPS);
#pragma unroll
                for (int j = 0; j < 4; ++j) xo[64 * j] = (unsigned long long)pk2(v[j][0], v[j][1]) | ((unsigned long long)pk2(v[j][2], v[j][3]) << 32);
                po[0] = (unsigned long long)pk2(pv[0], pv[1]) | ((unsigned long long)pk2(pv[2], pv[3]) << 32);
            } else {
                if (lane == 0) rstd0[m] = 0.f;
#pragma unroll
                for (int j = 0; j < 4; ++j) xo[64 * j] = 0ull;
                po[0] = 0ull;
            }
        }
        {
            const size_t gt = (size_t)vcu * NTHREADS + tid, GS = (size_t)G * NTHREADS;
#pragma unroll
            for (int g = 0; g < 3; ++g) {
                const int W = 128 << (2 * g); const float* cg = g == 0 ? cache0 : g == 1 ? cache1 : cache2;
                float* og = out + (g == 0 ? O_KV0S : g == 1 ? O_KV1S : O_KV2S);
                const size_t per4 = (size_t)(W - 4) * 128, tot4 = per4 * 32;
                for (size_t i = gt; i < tot4; i += GS) { const size_t bs = i / per4, r = i - bs * per4;
                    const f32x4 v = __builtin_nontemporal_load((const f32x4*)(cg + (bs * W + 4) * 512) + r);
                    __builtin_nontemporal_store(v, (f32x4*)(og + bs * W * 512) + r); }
            }
            const size_t per4 = 26 * 128, tot4 = per4 * 32;
            for (size_t i = gt; i < tot4; i += GS) { const size_t bs = i / per4, r = i - bs * per4;
                ((f32x4*)(out + O_CONVS + bs * 30 * 512))[r] = ((const f32x4*)(state_conv + (bs * 30 + 4) * 512))[r]; }
        }
        if (BOTH(0)) GRID_BAR();
    }

    if (IN(1)) {
        pg8::Gemm g{XB, Wi_t, MPAD, NIN, 1024}; pg8::StaticOrder S; S.init(MPAD, NIN, G, bx);
        pg8::EpiIn E{rstd0, U, Qb, Kb, Vb, GT, out};
        pg8::gemm_phase<pg8::EpiIn, pg8::StaticOrder, true, true>(lds, g, S, E);
        if (BOTH(1)) GRID_BAR();
    }

    if (IN(2)) {
#ifndef NO_ATT
        for (int un = vcu; un < 256; un += G) { const int b = un >> 6, slot = (un >> 4) & 3, sp = un & 15;
            LAS unsigned char* wl = lds + wave * ATT_WAVE_BYTES;
#pragma unroll 1
            for (int jj = 0; jj < 2; ++jj) att_job(Qb, Kb, Vb, OB, b, slot, sp, wave + 8 * jj, wl, lane); }
        __syncthreads();
#endif
#ifndef NO_CONV
        for (int ti = vcu; ti < 512; ti += G) conv_tile(U, CB, w_dw, b_dw, ln_g, ln_b, ti >> 7, (ti & 127) * 64, lds, tid);
#endif
#ifndef NO_SAMP
        for (int bs = vcu; bs < 32; bs += G) conv_sample(U, CB, state_conv, w_dw, b_dw, ln_g, ln_b, bs, lds, tid);
        for (int j = vcu; j < 512; j += G) att_sample(Qb, Kb, Vb, OB, cache0, cache1, cache2, j >> 4, (j >> 2) & 3, j & 3, lds, tid);
#endif
        if (BOTH(2)) GRID_BAR();
    }

    if (IN(3)) {
        { pg8::Gemm g{CB, Wc_t, MPAD, 1024, 512}; pg8::StaticOrder S; S.init(MPAD, 1024, G, bx); pg8::EpiGate E{GT, 0, MIX};
          pg8::gemm_phase<pg8::EpiGate, pg8::StaticOrder, true, true>(lds, g, S, E); }
        { pg8::Gemm g{OB, Wa_t, MPAD, 1024, 256}; pg8::StaticOrder S; S.init(MPAD, 1024, G, bx); pg8::EpiGateAdd E{GT, 1024, MIX};
          pg8::gemm_phase<pg8::EpiGateAdd, pg8::StaticOrder, true, true>(lds, g, S, E); }
        if (BOTH(3)) GRID_BAR();
    }

    if (IN(4)) {
        pg8::Gemm g{MIX, Wo_t, MPAD, 1024, 1024}; pg8::StaticOrder S; S.init(MPAD, 1024, G, bx); pg8::EpiResid E{x_prompt, x_sample, out, XB, ssq1};
        pg8::gemm_phase<pg8::EpiResid, pg8::StaticOrder, true, true>(lds, g, S, E);
        if (BOTH(4)) GRID_BAR();
    }

    if (IN(5)) {
        pg8::Gemm g{XB, Wu_t, MPAD, 2 * DFF, 1024}; pg8::StaticOrder S; S.init(MPAD, 2 * DFF, G, bx); pg8::EpiUp E{ssq1, HB};
        pg8::gemm_phase<pg8::EpiUp, pg8::StaticOrder, true, true>(lds, g, S, E);
        if (BOTH(5)) GRID_BAR();
    }

    if (IN(6)) {
        pg8::Gemm g{HB, Wd_t, MPAD, 1024, DFF}; pg8::StaticOrder S; S.init(MPAD, 1024, G, bx); pg8::EpiResid E{out, out + (size_t)MP * 1024, out, XB, ssq2};
        pg8::gemm_phase<pg8::EpiResid, pg8::StaticOrder, true, true>(lds, g, S, E);
        if (BOTH(6)) GRID_BAR();
    }

    if (IN(7)) {
        { pg8::Gemm g{PB, Wp_t, MPAD, 1024, 256}; pg8::StaticOrder S; S.init(MPAD, 1024, G, bx); pg8::EpiGate E{nullptr, 0, PP};
          pg8::gemm_phase<pg8::EpiGate, pg8::StaticOrder, true, true>(lds, g, S, E); }
        { pg8::Gemm g{XB, Wg_t, MPAD, 1024, 1024}; pg8::StaticOrder S; S.init(MPAD, 1024, G, bx); pg8::EpiPle E{ssq2, PP, out, ssq3};
          pg8::gemm_phase<pg8::EpiPle, pg8::StaticOrder, true, true>(lds, g, S, E); }
        if (BOTH(7)) GRID_BAR();
    }

    if (IN(8)) {
        f32x4 gf[4];
#pragma unroll
        for (int j = 0; j < 4; ++j) gf[j] = ((const GAS f32x4*)g_final)[lane + 64 * j];
        for (int m = gw; m < MR; m += NGW) {
            const float rs = pg8::rstd16(ssq3 + (size_t)m * 16);
            GAS f32x4* xr = (GAS f32x4*)(out + (size_t)m * 1024);
            f32x4 v[4];
#pragma unroll
            for (int j = 0; j < 4; ++j) v[j] = xr[lane + 64 * j];
#pragma unroll
            for (int j = 0; j < 4; ++j) xr[lane + 64 * j] = v[j] * rs * gf[j];
        }
    }
#ifdef DBG_DUMP
    if (lo == 9) {
        for (int m = gw; m < MR; m += NGW) {
            GAS f32x4* xr = (GAS f32x4*)(out + (size_t)m * 1024);
#pragma unroll
            for (int j = 0; j < 4; ++j) { const int c0 = 4 * (lane + 64 * j); f32x4 v = (f32x4){0.f, 0.f, 0.f, 0.f};
#if DBG_DUMP == 2
                if (c0 < 512) { const bf16* s = CB + (size_t)m * 512 + c0; v = (f32x4){bflo(s[0] | 0u) , 0.f, 0.f, 0.f}; v[0] = __uint_as_float((unsigned)s[0] << 16); v[1] = __uint_as_float((unsigned)s[1] << 16); v[2] = __uint_as_float((unsigned)s[2] << 16); v[3] = __uint_as_float((unsigned)s[3] << 16); }
                else if (c0 < 768) { const bf16* s = OB + (size_t)m * 256 + (c0 - 512); v[0] = __uint_as_float((unsigned)s[0] << 16); v[1] = __uint_as_float((unsigned)s[1] << 16); v[2] = __uint_as_float((unsigned)s[2] << 16); v[3] = __uint_as_float((unsigned)s[3] << 16); }
#endif
#if DBG_DUMP == 3
                { const bf16* s = MIX + (size_t)m * 1024 + c0; v[0] = __uint_as_float((unsigned)s[0] << 16); v[1] = __uint_as_float((unsigned)s[1] << 16); v[2] = __uint_as_float((unsigned)s[2] << 16); v[3] = __uint_as_float((unsigned)s[3] << 16); }
#endif
#if DBG_DUMP == 1
                { const bf16* s = GT + (size_t)m * 2048 + 1024 * (DBG_GTHALF) + c0; v[0] = __uint_as_float((unsigned)s[0] << 16); v[1] = __uint_as_float((unsigned)s[1] << 16); v[2] = __uint_as_float((unsigned)s[2] << 16); v[3] = __uint_as_float((unsigned)s[3] << 16); }
#endif
#if DBG_DUMP == 5
                { const bf16* s = HB + (size_t)m * DFF + c0; v[0] = __uint_as_float((unsigned)s[0] << 16); v[1] = __uint_as_float((unsigned)s[1] << 16); v[2] = __uint_as_float((unsigned)s[2] << 16); v[3] = __uint_as_float((unsigned)s[3] << 16); }
#endif
                xr[lane + 64 * j] = v; }
        }
    }
#endif
#undef IN
#undef BOTH
#undef GRID_BAR
}

extern "C" void kernel_launch(void* const* d_in, const int* in_sizes, int n_in, void* d_out, int out_size, void* d_ws, size_t ws_size, hipStream_t stream) {
    static int grid = 0;
    if (grid == 0) {
        if (n_in != 25 || (size_t)out_size != O_END || ws_size < WS_END) { fprintf(stderr, "kernel_launch: shape mismatch: n_in %d out %d ws %zu (need %zu)\n", n_in, out_size, ws_size, (size_t)WS_END); grid = -1; return; }
        int dev = 0, cus = 0;
        if (hipGetDevice(&dev) != hipSuccess || hipDeviceGetAttribute(&cus, hipDeviceAttributeMultiprocessorCount, dev) != hipSuccess) { grid = -1; return; }
        if (hipFuncSetAttribute((const void*)mega_fwd, hipFuncAttributeMaxDynamicSharedMemorySize, LDS_BYTES) != hipSuccess) { fprintf(stderr, "kernel_launch: hipFuncSetAttribute failed\n"); grid = -1; return; }
        int per_cu = 0;
        if (hipOccupancyMaxActiveBlocksPerMultiprocessor(&per_cu, (const void*)mega_fwd, NTHREADS, LDS_BYTES) != hipSuccess || per_cu < 1) fprintf(stderr, "kernel_launch: occupancy query says %d\n", per_cu);
        (void)hipGetLastError();
        grid = cus;
    }
    if (grid < 0) return;
    (void)hipMemsetAsync((char*)d_ws + WS_CTL, 0, CTL_ZERO_BYTES, stream);
    Args a{};
    for (int i = 0; i < 25; ++i) a.in[i] = (const float*)d_in[i];
    a.out = (float*)d_out; a.ws = (unsigned char*)d_ws;
    if (N_LAUNCHES == 1) { a.ph_lo = 0; a.ph_hi = NPHASE; hipLaunchKernelGGL(mega_fwd, dim3(grid), dim3(NTHREADS), LDS_BYTES, stream, a); }
    else {
#ifdef DBG_DUMP
        for (int li = 0; li <= DBG_DUMP; ++li) { a.ph_lo = li; a.ph_hi = li + 1; hipLaunchKernelGGL(mega_fwd, dim3(grid), dim3(NTHREADS), LDS_BYTES, stream, a); }
        if (DBG_DUMP == 1 || DBG_DUMP == 2 || DBG_DUMP == 3 || DBG_DUMP == 5) { a.ph_lo = 9; a.ph_hi = 10; hipLaunchKernelGGL(mega_fwd, dim3(grid), dim3(NTHREADS), LDS_BYTES, stream, a); }
#else
        for (int li = 0; li < NPHASE; ++li) { a.ph_lo = li; a.ph_hi = li + 1; hipLaunchKernelGGL(mega_fwd, dim3(grid), dim3(NTHREADS), LDS_BYTES, stream, a); }
#endif
    }
}
```

```cpp
#include <hip/hip_runtime.h>
#include <cstdio>
#include <cstdint>

namespace cfg {
constexpr int DM = 1024, SEQ = 8192, NBATCH = 4, MP = NBATCH * SEQ, NSEQ = 32, NTOK = 4, MS = NSEQ * NTOK, MR = MP + MS, MPAD = 33024;
constexpr int DCONV = 512, NIN = 5376, DFF = 2816, DPLE = 256, CWID = 31;
constexpr float EPS = 1e-6f;
constexpr float C2 = 0.125f * 1.4426950408889634f;
constexpr size_t O_Y = 0;
constexpr size_t O_CONVP = (size_t)MR * DM;
constexpr size_t O_CONVS = O_CONVP + (size_t)4 * 30 * 512;
constexpr size_t O_KV0P = O_CONVS + (size_t)32 * 30 * 512;
constexpr size_t O_KV0S = O_KV0P + (size_t)4 * 128 * 512;
constexpr size_t O_KV1P = O_KV0S + (size_t)32 * 128 * 512;
constexpr size_t O_KV1S = O_KV1P + (size_t)4 * 512 * 512;
constexpr size_t O_KV2P = O_KV1S + (size_t)32 * 512 * 512;
constexpr size_t O_KV2S = O_KV2P + (size_t)4 * 2048 * 512;
constexpr size_t O_END = O_KV2S + (size_t)32 * 2048 * 512;
static_assert(O_END == 83783680, "output size");
}
namespace pg8 {
#define PG8_LAS __attribute__((address_space(3)))
typedef unsigned short bf16_t;
typedef short bf16x8 __attribute__((ext_vector_type(8)));
typedef float f32x4 __attribute__((ext_vector_type(4)));
typedef unsigned u32x4 __attribute__((ext_vector_type(4)));
constexpr int BM = 256, BK = 64, HALF = 128, HTB = HALF * BK * 2  , STAGE_BYTES = 8 * HTB, NXCD = 8, WGM = 4;

__host__ __device__ __forceinline__ int lds_byte(int r, int c) { const int st = (r >> 4) * 2 + (c >> 5), rr = r & 15, cc = c & 31, ob = rr * 64 + cc * 2; return st * 1024 + (ob ^ (((ob >> 9) & 1) << 5)); }
__host__ __device__ __forceinline__ void stage_rc(int b, int& R, int& C) { const int st = b / 1024, sb = b % 1024, swz = sb ^ (((sb >> 9) & 1) << 5); R = (st >> 1) * 16 + swz / 64; C = (st & 1) * 32 + (swz % 64) / 2; }
__host__ __device__ __forceinline__ int perm32(int rho) { const int n = rho >> 4, i = rho & 15; return 8 * (i >> 2) + 4 * n + (i & 3); }

struct Unit { int pm, pn; };
struct Gemm { const bf16_t* A; const bf16_t* Bt; int M, N, K, ld; };

struct StaticOrder {
    int nM, nN, nwg, G, c;
    __host__ __device__ void init(int M, int N, int G_, int c_) { nM = M / BM; nN = N / BM; nwg = nM * nN; G = G_; c = c_; }
    __host__ __device__ bool next(int i, Unit& u) const {
        const long L = (long)i * G + c; if (L >= nwg) return false;
        int wgid = (int)L; { const int q = nwg / NXCD, r = nwg % NXCD, xcd = wgid % NXCD, off = wgid / NXCD; wgid = (xcd < r ? xcd * (q + 1) : r * (q + 1) + (xcd - r) * q) + off; }
        const int nig = WGM * nN, gid = wgid / nig, fm = gid * WGM, gsz = (nM - fm) < WGM ? (nM - fm) : WGM;
        u.pm = fm + ((wgid % nig) % gsz); u.pn = (wgid % nig) / gsz; return true;
    }
    __device__ __forceinline__ void a_ready(const Unit&) const {}
    __device__ __forceinline__ void done(const Unit&) const {}
};

typedef float f32x2c_t __attribute__((ext_vector_type(2))); typedef __bf16 bf16x2c_t __attribute__((ext_vector_type(2)));
__device__ __forceinline__ unsigned cvt_pk_bf16(float lo, float hi) { const f32x2c_t v = {lo, hi}; const bf16x2c_t b = __builtin_convertvector(v, bf16x2c_t); return __builtin_bit_cast(unsigned, b); }
typedef float f32x2 __attribute__((ext_vector_type(2)));
__device__ __forceinline__ float sigm(float x) { return __builtin_amdgcn_rcpf(1.0f + __builtin_amdgcn_exp2f(-1.4426950408889634f * x)); }
__device__ __forceinline__ u32x4 pack8(const f32x4 a, const f32x4 b) { u32x4 w; w.x = cvt_pk_bf16(a[0], a[1]); w.y = cvt_pk_bf16(a[2], a[3]); w.z = cvt_pk_bf16(b[0], b[1]); w.w = cvt_pk_bf16(b[2], b[3]); return w; }
__device__ __forceinline__ void unpack8(const u32x4 w, f32x4& a, f32x4& b) {
    a[0] = __uint_as_float(w.x << 16); a[1] = __uint_as_float(w.x & 0xffff0000u); a[2] = __uint_as_float(w.y << 16); a[3] = __uint_as_float(w.y & 0xffff0000u);
    b[0] = __uint_as_float(w.z << 16); b[1] = __uint_as_float(w.z & 0xffff0000u); b[2] = __uint_as_float(w.w << 16); b[3] = __uint_as_float(w.w & 0xffff0000u); }
__device__ __forceinline__ float dot4(const f32x4 a) { return (a[0] * a[0] + a[1] * a[1]) + (a[2] * a[2] + a[3] * a[3]); }
__device__ __forceinline__ float rstd16(const float* p) {
    const f32x4 a = *(const f32x4*)p, b = *(const f32x4*)(p + 4), c = *(const f32x4*)(p + 8), d = *(const f32x4*)(p + 12);
    const float s = (((a[0] + a[1]) + (a[2] + a[3])) + ((b[0] + b[1]) + (b[2] + b[3]))) + (((c[0] + c[1]) + (c[2] + c[3])) + ((d[0] + d[1]) + (d[2] + d[3])));
    return __builtin_amdgcn_rsqf(s * (1.0f / 1024.0f) + cfg::EPS);
}

struct RangeOrder : StaticOrder {
    int pm0; bool g16;
    __device__ __forceinline__ void init(int pm0_, int nMt, int N, int G_, int c_, bool g16_ = false) { StaticOrder::init(nMt * BM, N, G_, c_); pm0 = pm0_; g16 = g16_; }
    __device__ __forceinline__ bool next(int i, Unit& u) const {
        if (g16) { if (i * 16 + c >= nwg) return false; if (nN == 4) { u.pm = pm0 + 4 * i + (c & 3); u.pn = c >> 2; } else if (i < 10) { const int hs = i >= 5 ? 1 : 0, j = i - 5 * hs; u.pm = pm0 + 4 * hs + (c & 3); u.pn = 4 * j + (c >> 2); } else { u.pm = pm0 + (c & 7); u.pn = 20 + (c >> 3); } return true; }
        if (!StaticOrder::next(i, u)) return false; u.pm += pm0; return true; }
};

struct EpiIn {
    static constexpr bool PERM = true, AFTER_DRAIN = false, DRAINS = true; static constexpr int MID_T = 0;
    const float* rstd; bf16_t *U, *Q, *Kb, *Vb, *GT; float* out;
    __device__ __forceinline__ void operator()(const f32x4 (&acc)[2][2][4][2], const Unit& u, int wr, int wc, int fr, int fq) const {
        using namespace cfg;
        const int pn = u.pn, rbase = u.pm * BM + wr * 64 + fr, cl = wc * 32 + 8 * fq, tb = u.pm & 31;
        const bool smp = (u.pm == MP / BM);
        if (pn < 4) {
            const bool hasout = smp || tb == 31;
#pragma unroll
            for (int ai = 0; ai < 2; ++ai)
#pragma unroll
                for (int m = 0; m < 4; ++m) {
                    const int row = rbase + ai * HALF + m * 16; const float rs = rstd[row];
                    f32x4 a0 = acc[ai][0][m][0] * rs, a1 = acc[ai][0][m][1] * rs; const f32x4 b0 = acc[ai][1][m][0] * rs, b1 = acc[ai][1][m][1] * rs;
#pragma unroll
                    for (int e = 0; e < 4; ++e) { a0[e] *= sigm(b0[e]); a1[e] *= sigm(b1[e]); }
                    *(u32x4*)(U + (size_t)row * 512 + pn * 128 + cl) = pack8(a0, a1);
                    if (hasout) {
                        float* dst = nullptr;
                        if (!smp) { const int t = row & 8191; if (t >= 8162) dst = out + O_CONVP + (size_t)((row >> 13) * 30 + (t - 8162)) * 512; }
                        else if (row < MR) { const int si = row - MP; dst = out + O_CONVS + (size_t)((si >> 2) * 30 + 26 + (si & 3)) * 512; }
                        if (dst) { *(f32x4*)(dst + pn * 128 + cl) = a0; *(f32x4*)(dst + pn * 128 + cl + 4) = a1; }
                    }
                }
        } else if (pn < 7) {
            const int g = pn - 4;
#pragma unroll
            for (int ai = 0; ai < 2; ++ai)
#pragma unroll
                for (int m = 0; m < 4; ++m) {
                    const int row = rbase + ai * HALF + m * 16; const float rs = rstd[row] * C2;
#pragma unroll
                    for (int bj = 0; bj < 2; ++bj) *(u32x4*)(Q + (size_t)row * 768 + g * 256 + bj * HALF + cl) = pack8(acc[ai][bj][m][0] * rs, acc[ai][bj][m][1] * rs);
                }
        } else if (pn < 13) {
            const bool isV = pn >= 10; const int g = isV ? pn - 10 : pn - 7, sh = 2 * g, W = 128 << sh;
            bf16_t* base = isV ? Vb : Kb;
            const size_t offp = (g == 0 ? O_KV0P : g == 1 ? O_KV1P : O_KV2P) + (isV ? 256 : 0), offs = (g == 0 ? O_KV0S : g == 1 ? O_KV1S : O_KV2S) + (isV ? 256 : 0);
            const bool hasout = smp || (tb * 256 + 256 > 8192 - W);
#pragma unroll
            for (int ai = 0; ai < 2; ++ai)
#pragma unroll
                for (int m = 0; m < 4; ++m) {
                    const int row = rbase + ai * HALF + m * 16; const float rs = rstd[row];
                    int prow = row; float* dst = nullptr;
                    if (!smp) { const int t = row & 8191; prow = (row & ~8191) + ((t & ((1 << sh) - 1)) << (13 - sh)) + (t >> sh);
                        if (hasout && t >= 8192 - W) dst = out + offp + (size_t)((row >> 13) * W + (t - (8192 - W))) * 512; }
                    else if (row < MR) { const int si = row - MP; dst = out + offs + (size_t)((si >> 2) * W + (W - 4) + (si & 3)) * 512; }
#pragma unroll
                    for (int bj = 0; bj < 2; ++bj) { const f32x4 v0 = acc[ai][bj][m][0] * rs, v1 = acc[ai][bj][m][1] * rs;
                        *(u32x4*)(base + (size_t)prow * 768 + g * 256 + bj * HALF + cl) = pack8(v0, v1);
                        if (dst) { *(f32x4*)(dst + bj * HALF + cl) = v0; *(f32x4*)(dst + bj * HALF + cl + 4) = v1; } }
                }
        } else {
            const int j = pn - 13;
#pragma unroll
            for (int ai = 0; ai < 2; ++ai)
#pragma unroll
                for (int m = 0; m < 4; ++m) {
                    const int row = rbase + ai * HALF + m * 16; const float rs = rstd[row];
                    f32x4 c0 = acc[ai][0][m][0] * rs, c1 = acc[ai][0][m][1] * rs, a0 = acc[ai][1][m][0] * rs, a1 = acc[ai][1][m][1] * rs;
#pragma unroll
                    for (int e = 0; e < 4; ++e) {
                        const float e0 = 1.0f + fminf(__builtin_amdgcn_exp2f(-1.4426950408889634f * a0[e]), 0x1p60f), e1 = 1.0f + fminf(__builtin_amdgcn_exp2f(-1.4426950408889634f * a1[e]), 0x1p60f);
                        c0[e] = sigm(c0[e]) * e0; c1[e] = sigm(c1[e]) * e1; a0[e] = __builtin_amdgcn_rcpf(e0); a1[e] = __builtin_amdgcn_rcpf(e1); }
                    *(u32x4*)(GT + (size_t)row * 2048 + 128 * j + cl) = pack8(c0, c1);
                    *(u32x4*)(GT + (size_t)row * 2048 + 1024 + 128 * j + cl) = pack8(a0, a1);
                }
        }
    }
};
__device__ __forceinline__ void rstd_rows(const float* ssq, int rbase, int fq, float (&rs)[8]) {
    const int ai_o = fq >> 1, m_o = (fq & 1) * 2, lane = (int)__builtin_amdgcn_mbcnt_hi(~0u, __builtin_amdgcn_mbcnt_lo(~0u, 0u));
    const float* p0 = ssq + (size_t)(rbase + ai_o * HALF + m_o * 16) * 16;
    f32x4 t[8];
#pragma unroll
    for (int i = 0; i < 4; ++i) { t[i] = *(const f32x4*)(p0 + 4 * i); t[4 + i] = *(const f32x4*)(p0 + 256 + 4 * i); }
    float r[2];
#pragma unroll
    for (int k = 0; k < 2; ++k) { const f32x4 a = t[4 * k], b = t[4 * k + 1], c = t[4 * k + 2], d = t[4 * k + 3];
        const float sum = (((a[0] + a[1]) + (a[2] + a[3])) + ((b[0] + b[1]) + (b[2] + b[3]))) + (((c[0] + c[1]) + (c[2] + c[3])) + ((d[0] + d[1]) + (d[2] + d[3])));
        r[k] = __builtin_amdgcn_rsqf(sum * (1.0f / 1024.0f) + cfg::EPS); }
#pragma unroll
    for (int ai = 0; ai < 2; ++ai)
#pragma unroll
        for (int m = 0; m < 4; ++m) rs[ai * 4 + m] = __shfl((m & 1) ? r[1] : r[0], (lane & 15) + 16 * (ai * 2 + (m >> 1)));
}
struct EpiGate {
    static constexpr bool PERM = true, AFTER_DRAIN = false, DRAINS = false; static constexpr int MID_T = 0;
    const bf16_t* GT; int goff; bf16_t* O;
    __device__ __forceinline__ void operator()(const f32x4 (&acc)[2][2][4][2], const Unit& u, int wr, int wc, int fr, int fq) const {
        const int rbase = u.pm * BM + wr * 64 + fr, cb = u.pn * BM + wc * 32 + 8 * fq;
        u32x4 gv[2][4][2];
        if (GT) {
#pragma unroll
            for (int ai = 0; ai < 2; ++ai)
#pragma unroll
                for (int m = 0; m < 4; ++m)
#pragma unroll
                    for (int bj = 0; bj < 2; ++bj) gv[ai][m][bj] = *(const u32x4*)(GT + (size_t)(rbase + ai * HALF + m * 16) * 2048 + goff + cb + bj * HALF);
        }
#pragma unroll
        for (int ai = 0; ai < 2; ++ai)
#pragma unroll
            for (int m = 0; m < 4; ++m) { const int row = rbase + ai * HALF + m * 16;
#pragma unroll
                for (int bj = 0; bj < 2; ++bj) { const int col = cb + bj * HALF; f32x4 v0 = acc[ai][bj][m][0], v1 = acc[ai][bj][m][1];
                    if (GT) { f32x4 g0, g1; unpack8(gv[ai][m][bj], g0, g1); v0 = v0 * g0; v1 = v1 * g1; }
                    *(u32x4*)(O + (size_t)row * 1024 + col) = pack8(v0, v1); } }
    }
};
#ifndef MIXHOOK_T
#define MIXHOOK_T 8
#endif
struct EpiMix {
    static constexpr bool PERM = true, AFTER_DRAIN = false, DRAINS = true; static constexpr int MID_T = MIXHOOK_T;
    const bf16_t* GT; bf16_t* O;
    __device__ __forceinline__ void mid(f32x4 (&acc)[2][2][4][2], const Unit& u, int wr, int wc, int fr, int fq) const {
        const int rbase = u.pm * BM + wr * 64 + fr, cb = u.pn * BM + wc * 32 + 8 * fq;
#pragma unroll
        for (int ai = 0; ai < 2; ++ai) {
            u32x4 cv[4][2];
#pragma unroll
            for (int m = 0; m < 4; ++m)
#pragma unroll
                for (int bj = 0; bj < 2; ++bj) cv[m][bj] = *(const u32x4*)(GT + (size_t)(rbase + ai * HALF + m * 16) * 2048 + cb + bj * HALF);
#pragma unroll
            for (int m = 0; m < 4; ++m)
#pragma unroll
                for (int bj = 0; bj < 2; ++bj) { f32x4 c0, c1; unpack8(cv[m][bj], c0, c1); acc[ai][bj][m][0] = acc[ai][bj][m][0] * c0; acc[ai][bj][m][1] = acc[ai][bj][m][1] * c1; }
            asm volatile("" ::: "memory");
        }
    }
    __device__ __forceinline__ void operator()(const f32x4 (&acc)[2][2][4][2], const Unit& u, int wr, int wc, int fr, int fq) const {
        const int rbase = u.pm * BM + wr * 64 + fr, cb = u.pn * BM + wc * 32 + 8 * fq;
        u32x4 gv[2][4][2];
#pragma unroll
        for (int ai = 0; ai < 2; ++ai)
#pragma unroll
            for (int m = 0; m < 4; ++m)
#pragma unroll
                for (int bj = 0; bj < 2; ++bj) gv[ai][m][bj] = *(const u32x4*)(GT + (size_t)(rbase + ai * HALF + m * 16) * 2048 + 1024 + cb + bj * HALF);
#pragma unroll
        for (int ai = 0; ai < 2; ++ai)
#pragma unroll
            for (int m = 0; m < 4; ++m) { const int row = rbase + ai * HALF + m * 16;
#pragma unroll
                for (int bj = 0; bj < 2; ++bj) { f32x4 g0, g1; unpack8(gv[ai][m][bj], g0, g1);
                    *(u32x4*)(O + (size_t)row * 1024 + cb + bj * HALF) = pack8(acc[ai][bj][m][0] * g0, acc[ai][bj][m][1] * g1); } }
    }
};
struct EpiResidIn {
    static constexpr bool PERM = true, AFTER_DRAIN = false, DRAINS = true; static constexpr int MID_T = 0;
    const float* xp; const float* xs; bf16_t* XB; float* ssq;
    __device__ __forceinline__ void operator()(const f32x4 (&acc)[2][2][4][2], const Unit& u, int wr, int wc, int fr, int fq) const {
        using namespace cfg;
        const int rbase = u.pm * BM + wr * 64 + fr, cb = u.pn * BM + wc * 32 + 8 * fq;
#pragma unroll
        for (int ai = 0; ai < 2; ++ai) {
            f32x4 xv[4][2][2];
#pragma unroll
            for (int m = 0; m < 4; ++m) { const int row = rbase + ai * HALF + m * 16; const float* src = row < MP ? xp + (size_t)row * 1024 : xs + (size_t)(row - MP) * 1024;
#pragma unroll
                for (int bj = 0; bj < 2; ++bj) { xv[m][bj][0] = (f32x4){0.f, 0.f, 0.f, 0.f}; xv[m][bj][1] = xv[m][bj][0];
                    if (row < MR) { xv[m][bj][0] = *(const f32x4*)(src + cb + bj * HALF); xv[m][bj][1] = *(const f32x4*)(src + cb + bj * HALF + 4); } } }
#pragma unroll
            for (int m = 0; m < 4; ++m) { const int row = rbase + ai * HALF + m * 16; float q = 0.f;
#pragma unroll
                for (int bj = 0; bj < 2; ++bj) { const f32x4 x0 = xv[m][bj][0] + acc[ai][bj][m][0], x1 = xv[m][bj][1] + acc[ai][bj][m][1];
                    *(u32x4*)(XB + (size_t)row * 1024 + cb + bj * HALF) = pack8(x0, x1); q += dot4(x0) + dot4(x1); }
                q += __shfl_xor(q, 16); q += __shfl_xor(q, 32);
                if (fq == 0) ssq[(size_t)row * 16 + u.pn * 4 + wc] = q; }
            asm volatile("" ::: "memory");
        }
    }
};
struct EpiResidB {
    static constexpr bool PERM = true, AFTER_DRAIN = false, DRAINS = true; static constexpr int MID_T = 0;
    bf16_t* XB; float* ssq;
    __device__ __forceinline__ void operator()(const f32x4 (&acc)[2][2][4][2], const Unit& u, int wr, int wc, int fr, int fq) const {
        const int rbase = u.pm * BM + wr * 64 + fr, cb = u.pn * BM + wc * 32 + 8 * fq;
        u32x4 xv[2][4][2];
#pragma unroll
        for (int ai = 0; ai < 2; ++ai)
#pragma unroll
            for (int m = 0; m < 4; ++m)
#pragma unroll
                for (int bj = 0; bj < 2; ++bj) xv[ai][m][bj] = *(const u32x4*)(XB + (size_t)(rbase + ai * HALF + m * 16) * 1024 + cb + bj * HALF);
#pragma unroll
        for (int ai = 0; ai < 2; ++ai)
#pragma unroll
            for (int m = 0; m < 4; ++m) { const int row = rbase + ai * HALF + m * 16; float q = 0.f;
#pragma unroll
                for (int bj = 0; bj < 2; ++bj) { f32x4 x0, x1; unpack8(xv[ai][m][bj], x0, x1); x0 = x0 + acc[ai][bj][m][0]; x1 = x1 + acc[ai][bj][m][1];
                    *(u32x4*)(XB + (size_t)row * 1024 + cb + bj * HALF) = pack8(x0, x1); q += dot4(x0) + dot4(x1); }
                q += __shfl_xor(q, 16); q += __shfl_xor(q, 32);
                if (fq == 0) ssq[(size_t)row * 16 + u.pn * 4 + wc] = q; }
    }
};
struct EpiUp {
    static constexpr bool PERM = true, AFTER_DRAIN = false, DRAINS = true; static constexpr int MID_T = 0;
    const float* ssq; bf16_t* H; const float *c0, *c1, *c2, *st; float* out;
    __device__ __forceinline__ bool cp_addr(unsigned i, const f32x4*& src, f32x4*& dst) const {
        using namespace cfg;
        constexpr unsigned P0 = 124 * 128, T0 = P0 * 32, P1 = 508 * 128, T1 = P1 * 32, P2 = 2044 * 128, T2 = P2 * 32, P3 = 26 * 128, T3 = P3 * 32;
        if (i < T0) { const unsigned bs = i / P0, r = i - bs * P0; src = (const f32x4*)(c0 + ((size_t)bs * 128 + 4) * 512) + r; dst = (f32x4*)(out + O_KV0S + (size_t)bs * 128 * 512) + r; return true; }
        i -= T0;
        if (i < T1) { const unsigned bs = i / P1, r = i - bs * P1; src = (const f32x4*)(c1 + ((size_t)bs * 512 + 4) * 512) + r; dst = (f32x4*)(out + O_KV1S + (size_t)bs * 512 * 512) + r; return true; }
        i -= T1;
        if (i < T2) { const unsigned bs = i / P2, r = i - bs * P2; src = (const f32x4*)(c2 + ((size_t)bs * 2048 + 4) * 512) + r; dst = (f32x4*)(out + O_KV2S + (size_t)bs * 2048 * 512) + r; return true; }
        i -= T2;
        if (i < T3) { const unsigned bs = i / P3, r = i - bs * P3; src = (const f32x4*)(st + ((size_t)bs * 30 + 4) * 512) + r; dst = (f32x4*)(out + O_CONVS + (size_t)bs * 30 * 512) + r; return true; }
        return false;
    }
    __device__ __forceinline__ void operator()(const f32x4 (&acc)[2][2][4][2], const Unit& u, int wr, int wc, int fr, int fq) const {
        const int rbase = u.pm * BM + wr * 64 + fr, cl = u.pn * HALF + wc * 32 + 8 * fq;
        const unsigned tid = (unsigned)((wr * 4 + wc) * 64 + fr + 16 * fq), chunk = (unsigned)(u.pm * 22 + u.pn);
        f32x4 cv[8]; f32x4* cd[8]; bool ok[8];
#pragma unroll
        for (int k = 0; k < 8; ++k) { const f32x4* sp_; ok[k] = cp_addr((chunk * 8 + k) * 512 + tid, sp_, cd[k]); if (ok[k]) cv[k] = __builtin_nontemporal_load(sp_); }
        float rsv[8]; rstd_rows(ssq, rbase, fq, rsv);
#pragma unroll
        for (int ai = 0; ai < 2; ++ai)
#pragma unroll
            for (int m = 0; m < 4; ++m) { const int row = rbase + ai * HALF + m * 16; const float rs = rsv[ai * 4 + m];
                f32x4 g0 = acc[ai][0][m][0] * rs, g1 = acc[ai][0][m][1] * rs; const f32x4 u0 = acc[ai][1][m][0] * rs, u1 = acc[ai][1][m][1] * rs;
#pragma unroll
                for (int e = 0; e < 4; ++e) { g0[e] = g0[e] * sigm(g0[e]) * u0[e]; g1[e] = g1[e] * sigm(g1[e]) * u1[e]; }
                *(u32x4*)(H + (size_t)row * cfg::DFF + cl) = pack8(g0, g1); }
#pragma unroll
        for (int k = 0; k < 8; ++k) if (ok[k]) __builtin_nontemporal_store(cv[k], cd[k]);
    }
};
struct EpiNull {
    static constexpr bool PERM = true, AFTER_DRAIN = false, DRAINS = false; static constexpr int MID_T = 0;
    __device__ __forceinline__ void operator()(const f32x4 (&acc)[2][2][4][2], const Unit& u, int wr, int wc, int fr, int fq) const {
#pragma unroll
        for (int ai = 0; ai < 2; ++ai)
#pragma unroll
            for (int bj = 0; bj < 2; ++bj)
#pragma unroll
                for (int m = 0; m < 4; ++m) { asm volatile("" :: "v"(acc[ai][bj][m][0]), "v"(acc[ai][bj][m][1])); }
    }
};
struct EpiPleNorm {
    static constexpr bool PERM = true, AFTER_DRAIN = false, DRAINS = true; static constexpr int MID_T = 0;
    const float* ssq2; const bf16_t* PP; const bf16_t* XB; float* out; float* ssq3; unsigned* pcnt; const float* gfin; unsigned* tmo; PG8_LAS float* part;
    __device__ __forceinline__ void operator()(const f32x4 (&acc_)[2][2][4][2], const Unit& u, int wr, int wc, int fr, int fq) const {
        using namespace cfg;
        f32x4 (&acc)[2][2][4][2] = const_cast<f32x4 (&)[2][2][4][2]>(acc_);
        const int rbase = u.pm * BM + wr * 64 + fr, cb = u.pn * BM + wc * 32 + 8 * fq, lane = fr + 16 * fq, tid = (wr * 4 + wc) * 64 + lane;
        float rsv[8]; rstd_rows(ssq2, rbase, fq, rsv);
#pragma unroll
        for (int ai = 0; ai < 2; ++ai) {
            u32x4 pv[4][2], xv[4][2];
#pragma unroll
            for (int m = 0; m < 4; ++m)
#pragma unroll
                for (int bj = 0; bj < 2; ++bj) { const size_t ro = (size_t)(rbase + ai * HALF + m * 16) * 1024 + cb + bj * HALF; pv[m][bj] = *(const u32x4*)(PP + ro); xv[m][bj] = *(const u32x4*)(XB + ro); }
#pragma unroll
            for (int m = 0; m < 4; ++m) { const int rl = wr * 64 + fr + ai * HALF + m * 16; const float rs = rsv[ai * 4 + m]; float q = 0.f;
#pragma unroll
                for (int bj = 0; bj < 2; ++bj) { f32x4 x0, x1, p0, p1; unpack8(pv[m][bj], p0, p1); unpack8(xv[m][bj], x0, x1);
                    const f32x4 s0 = acc[ai][bj][m][0] * rs, s1 = acc[ai][bj][m][1] * rs;
#pragma unroll
                    for (int e = 0; e < 4; ++e) { x0[e] += sigm(s0[e]) * p0[e]; x1[e] += sigm(s1[e]) * p1[e]; }
                    acc[ai][bj][m][0] = x0; acc[ai][bj][m][1] = x1; q += dot4(x0) + dot4(x1); }
                q += __shfl_xor(q, 16); q += __shfl_xor(q, 32);
                if (fq == 0) part[rl * 4 + wc] = q; }
            asm volatile("" ::: "memory");
        }
        asm volatile("s_waitcnt lgkmcnt(0)" ::: "memory"); __builtin_amdgcn_s_barrier(); asm volatile("" ::: "memory");
        if (tid < 256) { const f32x4 p4 = *(const PG8_LAS f32x4*)(part + tid * 4);
            __hip_atomic_store(ssq3 + (size_t)(u.pm * BM + tid) * 4 + u.pn, (p4[0] + p4[1]) + (p4[2] + p4[3]), __ATOMIC_RELAXED, __HIP_MEMORY_SCOPE_AGENT); }
        asm volatile("s_waitcnt vmcnt(0)" ::: "memory"); __builtin_amdgcn_s_barrier(); asm volatile("" ::: "memory");
        unsigned* cw = pcnt + 64 * u.pm;
        if (tid == 0) __hip_atomic_fetch_add(cw, 1u, __ATOMIC_RELAXED, __HIP_MEMORY_SCOPE_AGENT);
        { unsigned sp = 0;
            while ((unsigned)__builtin_amdgcn_readfirstlane(__hip_atomic_load(cw, __ATOMIC_RELAXED, __HIP_MEMORY_SCOPE_AGENT)) < 4u) {
                __builtin_amdgcn_s_sleep(2);
                if (++sp > (1u << 20)) { if (lane == 0) __hip_atomic_store(tmo, 1u, __ATOMIC_RELAXED, __HIP_MEMORY_SCOPE_AGENT); break; } }
            __builtin_amdgcn_fence(__ATOMIC_ACQUIRE, "agent"); }
        float r3[8];
        { const int ai_o = fq >> 1, m_o = (fq & 1) * 2; const float* p0 = ssq3 + (size_t)(rbase + ai_o * HALF + m_o * 16) * 4;
          const f32x4 a = *(const f32x4*)p0, b = *(const f32x4*)(p0 + 64);
          const float ra = __builtin_amdgcn_rsqf(((a[0] + a[1]) + (a[2] + a[3])) * (1.0f / 1024.0f) + EPS), rb = __builtin_amdgcn_rsqf(((b[0] + b[1]) + (b[2] + b[3])) * (1.0f / 1024.0f) + EPS);
#pragma unroll
          for (int ai = 0; ai < 2; ++ai)
#pragma unroll
              for (int m = 0; m < 4; ++m) r3[ai * 4 + m] = __shfl((m & 1) ? rb : ra, fr + 16 * (ai * 2 + (m >> 1))); }
        f32x4 gv[2][2];
#pragma unroll
        for (int bj = 0; bj < 2; ++bj) { gv[bj][0] = *(const f32x4*)(gfin + cb + bj * HALF); gv[bj][1] = *(const f32x4*)(gfin + cb + bj * HALF + 4); }
#pragma unroll
        for (int ai = 0; ai < 2; ++ai)
#pragma unroll
            for (int m = 0; m < 4; ++m) { const int row = rbase + ai * HALF + m * 16; const float rs = r3[ai * 4 + m]; float* dst = out + (size_t)row * 1024;
                if (row < MR) {
#pragma unroll
                    for (int bj = 0; bj < 2; ++bj) { *(f32x4*)(dst + cb + bj * HALF) = acc[ai][bj][m][0] * rs * gv[bj][0]; *(f32x4*)(dst + cb + bj * HALF + 4) = acc[ai][bj][m][1] * rs * gv[bj][1]; } } }
    }
};

template <class Epi, class Sched, bool ALIGN_EPI = false, bool SP2 = false>
__device__ __forceinline__ void gemm_phase(PG8_LAS unsigned char* lds, const Gemm g, const Sched& S, const Epi& E, const int wave_id  ) {
    unsigned z_ = 0u; asm volatile("" : "+s"(z_)); int tid_ = wave_id * 64 + (int)__builtin_amdgcn_mbcnt_hi(~0u, __builtin_amdgcn_mbcnt_lo(~0u, z_)); asm volatile("" : "+v"(tid_));
    const int tid = tid_, wid = __builtin_amdgcn_readfirstlane(tid >> 6), lane = tid & 63, wr = wid >> 2, wc = wid & 3, fr = lane & 15, fq = lane >> 4;
    const int K = g.K, nt = K / BK, LD = g.ld;
    unsigned voffA[2], voffB[2];
#pragma unroll
    for (int i = 0; i < 2; ++i) { int R, C; stage_rc(tid * 16 + i * 8192, R, C); const int Rb = Epi::PERM ? ((R & ~31) + perm32(R & 31)) : R;
        voffA[i] = (unsigned)(R * LD + C) * 2u; voffB[i] = (unsigned)(Rb * LD + C) * 2u; }
    const size_t kstep = (size_t)(BK * 2);
    const size_t hstep = (size_t)HALF * LD * 2;
    const size_t tstep = 2 * hstep;
    const unsigned ldsw = (unsigned)wid * 1024u;
    const int aoff = lds_byte(wr * 64 + fr, fq * 8), boff = lds_byte(wc * 32 + fr, fq * 8);
#define PG8_SA(b, h) (((b) * 2 + (h)) * HTB)
#define PG8_SB(b, h) ((4 + (b) * 2 + (h)) * HTB)
#define PG8_STAGE(bufoff, gbase, voff) do { _Pragma("unroll") for (int _i = 0; _i < 2; ++_i) \
        __builtin_amdgcn_global_load_lds((const unsigned*)((const char*)(gbase) + (voff)[_i]), (PG8_LAS unsigned*)(lds + (bufoff) + ldsw + _i * 8192), 16, 0, 0); } while (0)
#define PG8_LDA(dst, b, h) do { _Pragma("unroll") for (int m = 0; m < 4; ++m) _Pragma("unroll") for (int k = 0; k < 2; ++k) dst[m][k] = *(const PG8_LAS bf16x8*)(lds + PG8_SA(b, h) + aoff + m * 2048 + k * 1024); } while (0)
#define PG8_LDB(dst, b, h) do { _Pragma("unroll") for (int n = 0; n < 2; ++n) _Pragma("unroll") for (int k = 0; k < 2; ++k) dst[n][k] = *(const PG8_LAS bf16x8*)(lds + PG8_SB(b, h) + boff + n * 2048 + k * 1024); } while (0)
#define PG8_MMA(ai, bj, At, Bt) do { __builtin_amdgcn_s_setprio(1); _Pragma("unroll") for (int m = 0; m < 4; ++m) _Pragma("unroll") for (int n = 0; n < 2; ++n) _Pragma("unroll") for (int k = 0; k < 2; ++k) \
        acc[ai][bj][m][n] = __builtin_amdgcn_mfma_f32_16x16x32_bf16(Bt[n][k], At[m][k], acc[ai][bj][m][n], 0, 0, 0); __builtin_amdgcn_s_setprio(0); } while (0)
#define PG8_WAIT_V(n) asm volatile("s_waitcnt vmcnt(" #n ")" ::: "memory")
#define PG8_WAIT_L(n) asm volatile("s_waitcnt lgkmcnt(" #n ")" ::: "memory")
#define PG8_BAR __builtin_amdgcn_s_barrier()
#define PG8_SCHED __builtin_amdgcn_sched_barrier(0)
    Unit cur, nxt; int ui = 0;
    if (!S.next(0, cur)) return;
    f32x4 acc[2][2][4][2];
#pragma unroll
    for (int a = 0; a < 2; ++a)
#pragma unroll
        for (int b = 0; b < 2; ++b)
#pragma unroll
            for (int m = 0; m < 4; ++m)
#pragma unroll
                for (int n = 0; n < 2; ++n) acc[a][b][m][n] = (f32x4){0.f, 0.f, 0.f, 0.f};
    bf16x8 At[4][2], B0[2][2], B1[2][2];
    const char* cA = (const char*)g.A + (size_t)cur.pm * tstep; const char* cB = (const char*)g.Bt + (size_t)cur.pn * tstep;
    S.a_ready(cur);
    if constexpr (SP2) {
        PG8_STAGE(PG8_SB(0, 0), cB, voffB); PG8_STAGE(PG8_SB(0, 1), cB + hstep, voffB); PG8_STAGE(PG8_SA(0, 0), cA, voffA); PG8_STAGE(PG8_SA(0, 1), cA + hstep, voffA);
        if (wr == 1) PG8_BAR;
        PG8_WAIT_V(2); PG8_BAR;
        PG8_STAGE(PG8_SB(1, 0), cB + kstep, voffB); PG8_STAGE(PG8_SA(1, 0), cA + kstep, voffA); PG8_STAGE(PG8_SB(1, 1), cB + hstep + kstep, voffB);
        PG8_WAIT_V(6); PG8_BAR;
    } else {
        PG8_STAGE(PG8_SB(0, 0), cB, voffB); PG8_STAGE(PG8_SA(0, 0), cA, voffA); PG8_STAGE(PG8_SB(0, 1), cB + hstep, voffB); PG8_STAGE(PG8_SA(0, 1), cA + hstep, voffA);
        if (wr == 1) PG8_BAR;
        PG8_WAIT_V(4); PG8_BAR;
        PG8_STAGE(PG8_SB(1, 0), cB + kstep, voffB); PG8_STAGE(PG8_SA(1, 0), cA + kstep, voffA); PG8_STAGE(PG8_SB(1, 1), cB + hstep + kstep, voffB);
        PG8_WAIT_V(6); PG8_BAR;
    }
    for (;;) {
        const bool has_next = S.next(ui + 1, nxt);
        const char* nA = has_next ? (const char*)g.A + (size_t)nxt.pm * tstep : cA; const char* nB = has_next ? (const char*)g.Bt + (size_t)nxt.pn * tstep : cB;
        for (int t = 0; t < nt; t += 2) {
            if constexpr (Epi::MID_T > 0) { if (t == Epi::MID_T) {
                unsigned z3_ = 0u; asm volatile("" : "+s"(z3_)); int l3_ = (int)__builtin_amdgcn_mbcnt_hi(~0u, __builtin_amdgcn_mbcnt_lo(~0u, z3_)); asm volatile("" : "+v"(l3_));
                E.mid(acc, cur, wr, wc, l3_ & 15, l3_ >> 4); } }
            const bool last = (t == nt - 2);
            const char* a1 = cA + (size_t)(t + 1) * kstep;
            const char* a2 = last ? nA : cA + (size_t)(t + 2) * kstep; const char* b2 = last ? nB : cB + (size_t)(t + 2) * kstep;
            const char* a3 = a2 + kstep; const char* b3 = b2 + kstep;
            if (last && has_next) S.a_ready(nxt);
            if constexpr (SP2) {
            PG8_LDB(B0, 0, 0); PG8_LDB(B1, 0, 1); PG8_SCHED; PG8_LDA(At, 0, 0); PG8_STAGE(PG8_SA(1, 1), a1 + hstep, voffA);
            PG8_WAIT_V(8); PG8_WAIT_L(0); PG8_BAR; PG8_MMA(0, 0, At, B0); PG8_MMA(0, 1, At, B1); PG8_BAR; PG8_SCHED;
            PG8_LDA(At, 0, 1); PG8_STAGE(PG8_SB(0, 0), b2, voffB); PG8_STAGE(PG8_SB(0, 1), b2 + hstep, voffB); PG8_STAGE(PG8_SA(0, 0), a2, voffA);
            PG8_WAIT_V(8); PG8_WAIT_L(0); PG8_BAR; PG8_MMA(1, 0, At, B0); PG8_MMA(1, 1, At, B1); PG8_BAR; PG8_SCHED;
            PG8_LDB(B0, 1, 0); PG8_LDB(B1, 1, 1); PG8_SCHED; PG8_LDA(At, 1, 0); PG8_STAGE(PG8_SA(0, 1), a2 + hstep, voffA);
            PG8_WAIT_V(8); PG8_WAIT_L(0); PG8_BAR; PG8_MMA(0, 0, At, B0); PG8_MMA(0, 1, At, B1); PG8_BAR; PG8_SCHED;
            PG8_LDA(At, 1, 1); PG8_STAGE(PG8_SB(1, 0), b3, voffB); PG8_STAGE(PG8_SB(1, 1), b3 + hstep, voffB); PG8_STAGE(PG8_SA(1, 0), a3, voffA);
            PG8_WAIT_V(8); PG8_WAIT_L(0); PG8_BAR; PG8_MMA(1, 0, At, B0); PG8_MMA(1, 1, At, B1); PG8_BAR; PG8_SCHED;
            } else {
            PG8_LDB(B0, 0, 0); PG8_SCHED; PG8_LDA(At, 0, 0); PG8_STAGE(PG8_SA(1, 1), a1 + hstep, voffA);
            PG8_WAIT_L(8); PG8_BAR; PG8_WAIT_L(0); PG8_MMA(0, 0, At, B0); PG8_BAR; PG8_SCHED;
            PG8_LDB(B1, 0, 1); PG8_STAGE(PG8_SB(0, 0), b2, voffB);
            PG8_BAR; PG8_WAIT_L(0); PG8_MMA(0, 1, At, B1); PG8_BAR;
            PG8_LDA(At, 0, 1); PG8_STAGE(PG8_SA(0, 0), a2, voffA);
            PG8_BAR; PG8_WAIT_L(0); PG8_MMA(1, 0, At, B0); PG8_BAR; PG8_SCHED;
            PG8_STAGE(PG8_SB(0, 1), b2 + hstep, voffB);
            PG8_WAIT_V(6); PG8_BAR; PG8_MMA(1, 1, At, B1); PG8_BAR;
            PG8_LDB(B0, 1, 0); PG8_SCHED; PG8_LDA(At, 1, 0); PG8_STAGE(PG8_SA(0, 1), a2 + hstep, voffA);
            PG8_WAIT_L(8); PG8_BAR; PG8_WAIT_L(0); PG8_MMA(0, 0, At, B0); PG8_BAR; PG8_SCHED;
            PG8_LDB(B1, 1, 1); PG8_STAGE(PG8_SB(1, 0), b3, voffB);
            PG8_BAR; PG8_WAIT_L(0); PG8_MMA(0, 1, At, B1); PG8_BAR;
            PG8_LDA(At, 1, 1); PG8_STAGE(PG8_SA(1, 0), a3, voffA);
            PG8_BAR; PG8_WAIT_L(0); PG8_MMA(1, 0, At, B0); PG8_BAR; PG8_SCHED;
            PG8_STAGE(PG8_SB(1, 1), b3 + hstep, voffB);
            PG8_WAIT_V(6); PG8_BAR; PG8_MMA(1, 1, At, B1); PG8_BAR;
            }
        }
        if constexpr (ALIGN_EPI) { if (wr == 0) PG8_BAR; }
        if constexpr (!Epi::AFTER_DRAIN) {
            unsigned z2_ = 0u; asm volatile("" : "+s"(z2_)); int l2_ = (int)__builtin_amdgcn_mbcnt_hi(~0u, __builtin_amdgcn_mbcnt_lo(~0u, z2_)); asm volatile("" : "+v"(l2_));
            E(acc, cur, wr, wc, l2_ & 15, l2_ >> 4); S.done(cur); }
        if (!has_next) break;
#pragma unroll
        for (int a = 0; a < 2; ++a)
#pragma unroll
            for (int b = 0; b < 2; ++b)
#pragma unroll
                for (int m = 0; m < 4; ++m)
#pragma unroll
                    for (int n = 0; n < 2; ++n) acc[a][b][m][n] = (f32x4){0.f, 0.f, 0.f, 0.f};
        cur = nxt; cA = nA; cB = nB; ++ui;
        if constexpr (ALIGN_EPI) { if (wr == 1) PG8_BAR; }
    }
    PG8_WAIT_V(0);
    if constexpr (!ALIGN_EPI) { if (wr == 0) PG8_BAR; }
    PG8_BAR;
    if constexpr (Epi::AFTER_DRAIN) { E.fused(acc, cur, wr, wc, fr, fq, lds, wid, lane); S.done(cur); }
#undef PG8_SA
#undef PG8_SB
#undef PG8_STAGE
#undef PG8_LDA
#undef PG8_LDB
#undef PG8_MMA
#undef PG8_WAIT_V
#undef PG8_WAIT_L
#undef PG8_BAR
#undef PG8_SCHED
}
}
#define GAS __attribute__((address_space(1)))
#define LAS __attribute__((address_space(3)))
typedef unsigned short bf16;
typedef unsigned v4u __attribute__((ext_vector_type(4)));
typedef float f32x4 __attribute__((ext_vector_type(4)));
typedef short bf16x8 __attribute__((ext_vector_type(8)));
typedef GAS unsigned gu32;
typedef GAS unsigned long long gu64;
#define RLX_AGENT __ATOMIC_RELAXED, __HIP_MEMORY_SCOPE_AGENT
#define LDS_WAIT() asm volatile("s_waitcnt lgkmcnt(0)" ::: "memory")
#define VM_WAIT() asm volatile("s_waitcnt vmcnt(0)" ::: "memory")
__device__ __forceinline__ unsigned long long rt() { return __builtin_amdgcn_s_memrealtime(); }
__device__ __forceinline__ unsigned f2bf(float f) { unsigned u = __builtin_bit_cast(unsigned, f); return (u + 0x7fffu + ((u >> 16) & 1u)) >> 16; }
__device__ __forceinline__ unsigned pk2(float lo, float hi) { return f2bf(lo) | (f2bf(hi) << 16); }
#define XB_TMO      128
#define XB_XCNT(j)  (256  + 64 * (j))
#define XB_XSUB(j)  (1280 + 64 * (j))
#define XB_XGEN(j)  (2304 + 64 * (j))
#define XB_TOP      3328
#define XB_TOPGEN   3392
#define XCD_BAR_WORDS 3456
#define XB_SPIN_CAP (1u << 18)

__device__ __forceinline__ unsigned xb_ld(unsigned* p)              { return __hip_atomic_load(p, __ATOMIC_RELAXED, __HIP_MEMORY_SCOPE_AGENT); }
__device__ __forceinline__ unsigned xb_add(unsigned* p, unsigned v) { return __hip_atomic_fetch_add(p, v, __ATOMIC_RELAXED, __HIP_MEMORY_SCOPE_AGENT); }
__device__ __forceinline__ unsigned xb_xcc_id() { return (unsigned)__builtin_amdgcn_s_getreg((3 << 11) | 20) & 0xFu; }
#define XB_SPIN(cond, bar) do { unsigned _sp = 0; while (cond) { __builtin_amdgcn_s_sleep(1); \
    if ((++_sp & 255u) == 0u) { if (xb_ld(&(bar)[XB_TMO])) break; if (_sp > XB_SPIN_CAP) { atomicAdd(&(bar)[XB_TMO], 1u); break; } } } } while (0)

struct XcdBarrier {
    unsigned* bar; unsigned x; unsigned gsize;
    volatile LAS unsigned* st;
};

__device__ __forceinline__ XcdBarrier xcd_barrier_post(unsigned* bar, volatile LAS unsigned* st) {
    XcdBarrier b; b.bar = bar; b.x = xb_xcc_id(); b.st = st; b.gsize = 0u;
    if (threadIdx.x == 0) (void)xb_add(&bar[XB_XCNT(b.x)], 1u);
    return b;
}
__device__ __forceinline__ void xcd_barrier_complete(unsigned* bar, unsigned x, unsigned& nloc, unsigned& nx, unsigned gsize = 0u) {
    const unsigned G = gsize ? gsize : gridDim.x * gridDim.y * gridDim.z;
    unsigned sum, cnt, mine, sp = 0u;
    for (;;) {
        sum = 0u; cnt = 0u; mine = 0u;
#pragma unroll
        for (unsigned j = 0; j < 16; ++j) { const unsigned c = xb_ld(&bar[XB_XCNT(j)]); sum += c; cnt += (c > 0u) ? 1u : 0u; mine = (j == x) ? c : mine; }
        if (sum == G) break;
        __builtin_amdgcn_s_sleep(1);
        if ((++sp & 255u) == 0u) { if (xb_ld(&bar[XB_TMO])) break; if (sp > XB_SPIN_CAP) { atomicAdd(&bar[XB_TMO], 1u); break; } }
    }
    nloc = mine > 0u ? mine : 1u; nx = cnt > 0u ? cnt : 1u;
}

__device__ __forceinline__ void xcd_barrier(const XcdBarrier& b) {
    asm volatile("s_waitcnt vmcnt(0)" ::: "memory");
    __syncthreads();
    if (threadIdx.x == 0) {
        unsigned* bar = b.bar;
        __builtin_amdgcn_s_waitcnt(0);
        unsigned nloc = b.st[0], nx = b.st[1];
        if (nloc == 0u) { xcd_barrier_complete(bar, b.x, nloc, nx, b.gsize); b.st[0] = nloc; b.st[1] = nx; }
        const unsigned old = xb_add(&bar[XB_XSUB(b.x)], 1u);
        const unsigned gen = old / nloc;
        if (old + 1u == (gen + 1u) * nloc) {
            __builtin_amdgcn_fence(__ATOMIC_RELEASE, "agent");
            asm volatile("s_waitcnt vmcnt(0)" ::: "memory");
            const unsigned og = xb_add(&bar[XB_TOP], 1u);
            const unsigned tg = og / nx;
            if (og + 1u == (tg + 1u) * nx) xb_add(&bar[XB_TOPGEN], 1u);
            else XB_SPIN(xb_ld(&bar[XB_TOPGEN]) == tg, bar);
            __builtin_amdgcn_fence(__ATOMIC_ACQUIRE, "agent");
            xb_add(&bar[XB_XGEN(b.x)], 1u);
            asm volatile("s_waitcnt vmcnt(0)" ::: "memory");
        } else {
            XB_SPIN(xb_ld(&bar[XB_XGEN(b.x)]) == gen, bar);
            __builtin_amdgcn_fence(__ATOMIC_ACQUIRE, "agent");
            asm volatile("s_waitcnt vmcnt(0)" ::: "memory");
        }
    }
    __syncthreads();
}


using namespace cfg;
constexpr int NWAVES = 8, NTHREADS = 512;
#ifndef MK_N_LAUNCHES
#define MK_N_LAUNCHES 1
#endif
constexpr int NPHASE = 9;
constexpr int N_LAUNCHES = MK_N_LAUNCHES;

constexpr size_t MiB = 1u << 20;
constexpr size_t WS_CTL = 0, CTL_ZERO_BYTES = 400 * 1024;
constexpr size_t WS_RSTD0 = 1 * MiB, WS_SSQ1 = 2 * MiB, WS_SSQ2 = 5 * MiB, WS_SSQ3 = 8 * MiB;
constexpr size_t WS_W_IN = 12 * MiB, WS_W_C = 23 * MiB, WS_W_A = 24 * MiB, WS_W_O = 25 * MiB, WS_W_UP = 27 * MiB, WS_W_DN = 38 * MiB, WS_W_PG = 44 * MiB, WS_W_PL = 46 * MiB;
constexpr size_t WS_PB = 48 * MiB;
constexpr size_t WS_XB = 66 * MiB;
constexpr size_t WS_CO = WS_XB;
constexpr size_t WS_R1 = 132 * MiB;
constexpr size_t WS_U = WS_R1, WS_Q = WS_R1 + 33 * MiB, WS_K = WS_R1 + 82 * MiB, WS_V = WS_R1 + 131 * MiB;
constexpr size_t WS_MIX = WS_R1, WS_H = WS_R1;
constexpr size_t WS_GT = 312 * MiB;
constexpr size_t WS_PP = 441 * MiB;
constexpr size_t WS_SMP = 506 * MiB;
constexpr size_t WS_SMP_CO = WS_SMP, WS_SMP_MIX = WS_SMP + 512 * 1024, WS_SMP_H = WS_SMP + 2 * MiB;
constexpr size_t WS_END = 510 * MiB;
static_assert(WS_PP + (size_t)MPAD * 1024 * 2 <= WS_SMP && WS_END <= 512 * MiB, "ws map 0");
static_assert(WS_V + (size_t)MPAD * 768 * 2 <= WS_GT && WS_H + (size_t)MPAD * DFF * 2 <= WS_GT && WS_GT + (size_t)MPAD * 2048 * 2 <= WS_END, "ws map");
static_assert(WS_CO + (size_t)MPAD * 768 * 2 <= WS_R1 && WS_PB + (size_t)MPAD * 256 * 2 <= WS_XB, "ws map 2");
static_assert(WS_W_IN + (size_t)NIN * 1024 * 2 <= WS_W_C && WS_W_UP + (size_t)2 * DFF * 1024 * 2 <= WS_W_DN && WS_W_DN + (size_t)DFF * 1024 * 2 <= WS_W_PG && WS_SSQ1 + (size_t)MPAD * 64 <= WS_SSQ2, "ws map 3");
constexpr int CW_BAR = 1024, CW_PBAR = 31744, CW_SBAR = 35200, CW_PFLAG = 38784, CW_GBAR = 40960;

constexpr int RING_BYTES = 131072, LDSCTL_OFF = RING_BYTES, MISC_OFF = LDSCTL_OFF + 320, LDS_BYTES = 147456;

struct Args { const float* in[25]; float* out; unsigned char* ws; int ph_lo, ph_hi; };

#define DPPF(v, ctrl) __builtin_bit_cast(float, __builtin_amdgcn_update_dpp(0, __builtin_bit_cast(int, (v)), (ctrl), 0xf, 0xf, false))
#define RDLF(v, l) __builtin_bit_cast(float, __builtin_amdgcn_readlane(__builtin_bit_cast(int, (v)), (l)))
__device__ __forceinline__ float wave_sum(float v) {
    v += DPPF(v, 0xB1); v += DPPF(v, 0x4E); v += DPPF(v, 0x141); v += DPPF(v, 0x140);
    return (RDLF(v, 0) + RDLF(v, 16)) + (RDLF(v, 32) + RDLF(v, 48));
}
__device__ __forceinline__ float wave_max(float v) {
    v = fmaxf(v, DPPF(v, 0xB1)); v = fmaxf(v, DPPF(v, 0x4E)); v = fmaxf(v, DPPF(v, 0x141)); v = fmaxf(v, DPPF(v, 0x140));
    return fmaxf(fmaxf(RDLF(v, 0), RDLF(v, 16)), fmaxf(RDLF(v, 32), RDLF(v, 48)));
}
__device__ __forceinline__ float bflo(unsigned w) { return __uint_as_float(w << 16); }
__device__ __forceinline__ float bfhi(unsigned w) { return __uint_as_float(w & 0xffff0000u); }
__device__ __forceinline__ float fsig(float x) { return __builtin_amdgcn_rcpf(1.0f + __builtin_amdgcn_exp2f(-1.4426950408889634f * x)); }

__device__ __forceinline__ void p0_transpose_item(const float* W, int ldw, int k0, int n0, bf16* WT, int ldt, int row0, const float* gk, LAS float* scr, int lane, int kd0 = 0) {
    { f32x4 t4[8];
#pragma unroll
        for (int i = 0; i < 8; ++i) { const int kk = 8 * i + (lane >> 3); t4[i] = *(const f32x4*)(W + (size_t)(k0 + kk) * ldw + n0 + 4 * (lane & 7)); }
#pragma unroll
        for (int i = 0; i < 8; ++i) { const int kk = 8 * i + (lane >> 3); const float gs = gk ? gk[k0 + kk] : 1.0f; LAS float* d = scr + kk * 33 + 4 * (lane & 7);
            d[0] = t4[i][0] * gs; d[1] = t4[i][1] * gs; d[2] = t4[i][2] * gs; d[3] = t4[i][3] * gs; } }
    LDS_WAIT(); asm volatile("" ::: "memory");
    const int c = lane & 7;
#pragma unroll
    for (int j = 0; j < 4; ++j) { const int n = (lane >> 3) + 8 * j; const LAS float* s = scr + (8 * c) * 33 + n;
        v4u o; o.x = pk2(s[0 * 33], s[1 * 33]); o.y = pk2(s[2 * 33], s[3 * 33]); o.z = pk2(s[4 * 33], s[5 * 33]); o.w = pk2(s[6 * 33], s[7 * 33]);
        *(GAS v4u*)(WT + (size_t)(row0 + n) * ldt + kd0 + k0 + 8 * c) = o; }
    LDS_WAIT(); asm volatile("" ::: "memory");
}
__device__ __forceinline__ void p0_mat_item(const float* W, int K, int ldw, int csrc0, int ncols, bf16* WT, int ldt, int row0, const float* gk, LAS float* scr, int it, int lane, int kd0 = 0) {
    const int nblk = ncols / 32, kb = it / nblk, nb = it % nblk;
    p0_transpose_item(W, ldw, 64 * kb, csrc0 + 32 * nb, WT, ldt, row0 + 32 * nb, gk, scr, lane, kd0);
}

typedef float f32x16 __attribute__((ext_vector_type(16)));
typedef short v4i16_t __attribute__((ext_vector_type(4)));
__device__ __forceinline__ int crow(int r, int hi) { return (r & 3) + 8 * (r >> 2) + 4 * hi; }
constexpr int VPITCH = 144;
constexpr int ATT_WSF = 32 * VPITCH, ATT_OST = ATT_WSF + 256, ATT_WAVE_BYTES = 9216;
static_assert(ATT_OST + 4096 <= ATT_WAVE_BYTES && ATT_WAVE_BYTES * NWAVES <= RING_BYTES, "attention LDS");

struct AttState { float m, l; f32x16 o0, o1; };

__device__ __forceinline__ void att_tile(const bool MASKED  , AttState& st, const bf16x8 (&kf)[4], const v4u (&vv)[4], const bf16x8 (&qf)[4], int n, int uq, float slope2,
                                         LAS unsigned char* wl, const LAS unsigned char* vtr0, int lane) {
    const int c = lane & 31, h = lane >> 5;
    LAS float* wsf = (LAS float*)(wl + ATT_WSF);
    f32x16 s = {};
#pragma unroll
    for (int k = 0; k < 4; ++k) s = __builtin_amdgcn_mfma_f32_32x32x16_bf16(kf[k], qf[k], s, 0, 0, 0);
#pragma unroll
    for (int i = 0; i < 4; ++i) *(LAS v4u*)(wl + (lane >> 1) * VPITCH + (lane & 1) * 64 + 16 * i) = vv[i];
    asm volatile("" ::: "memory");
    const int dbase = uq - 32 * n - 4 * h;
    const float tc = -slope2 * (float)dbase;
    float mx = -INFINITY;
    if (MASKED) {
#pragma unroll
        for (int r = 0; r < 16; ++r) { const int ko = (r & 3) + 8 * (r >> 2); s[r] = ((unsigned)(dbase - ko) <= 128u) ? s[r] : -INFINITY; }
    }
#pragma unroll
    for (int r = 0; r < 16; ++r) { const int ko = (r & 3) + 8 * (r >> 2); s[r] += slope2 * (float)ko; mx = fmaxf(mx, s[r]); }
    mx += tc; { const auto sw = __builtin_amdgcn_permlane32_swap(__float_as_uint(mx), __float_as_uint(mx), false, false); mx = fmaxf(__uint_as_float(sw[0]), __uint_as_float(sw[1])); }
    if (__any(mx > st.m + 8.0f)) {
        const float mnew = fmaxf(st.m, mx), f = __builtin_amdgcn_exp2f(st.m - mnew);
        st.l *= f; st.m = mnew;
        if (h == 0) wsf[c] = f;
        asm volatile("" ::: "memory");
#pragma unroll
        for (int r = 0; r < 16; ++r) { const float fr_ = wsf[crow(r, h)]; st.o0[r] *= fr_; st.o1[r] *= fr_; }
        asm volatile("" ::: "memory");
    }
    const float off = tc - st.m; float ps = 0.f;
#pragma unroll
    for (int r = 0; r < 16; ++r) { s[r] = __builtin_amdgcn_exp2f(s[r] + off); ps += s[r]; }
    st.l += ps;
    v4u pw0, pw1;
    pw0.x = pg8::cvt_pk_bf16(s[0], s[1]); pw0.y = pg8::cvt_pk_bf16(s[2], s[3]); pw0.z = pg8::cvt_pk_bf16(s[4], s[5]); pw0.w = pg8::cvt_pk_bf16(s[6], s[7]);
    pw1.x = pg8::cvt_pk_bf16(s[8], s[9]); pw1.y = pg8::cvt_pk_bf16(s[10], s[11]); pw1.z = pg8::cvt_pk_bf16(s[12], s[13]); pw1.w = pg8::cvt_pk_bf16(s[14], s[15]);
    const bf16x8 pa0 = __builtin_bit_cast(bf16x8, pw0), pa1 = __builtin_bit_cast(bf16x8, pw1);
#pragma unroll
    for (int nb = 0; nb < 2; ++nb)
#pragma unroll
        for (int ks = 0; ks < 2; ++ks) {
            const LAS unsigned char* p = vtr0 + (16 * ks) * VPITCH + 64 * nb;
            const v4i16_t lo = __builtin_amdgcn_ds_read_tr16_b64_v4i16((LAS v4i16_t*)p);
            const v4i16_t hi = __builtin_amdgcn_ds_read_tr16_b64_v4i16((LAS v4i16_t*)(p + 8 * VPITCH));
            const bf16x8 vf = (bf16x8){lo[0], lo[1], lo[2], lo[3], hi[0], hi[1], hi[2], hi[3]};
            if (nb == 0) st.o0 = __builtin_amdgcn_mfma_f32_32x32x16_bf16(ks == 0 ? pa0 : pa1, vf, st.o0, 0, 0, 0);
            else         st.o1 = __builtin_amdgcn_mfma_f32_32x32x16_bf16(ks == 0 ? pa0 : pa1, vf, st.o1, 0, 0, 0);
        }
    asm volatile("" ::: "memory");
}
constexpr int ATT2_WAVE_BYTES = 4864, ATT2_COMB = 40960, ATT2_LSE = ATT2_COMB + 65536;
static_assert(ATT2_WAVE_BYTES >= ATT_WSF + 256 && ATT2_WAVE_BYTES * NWAVES <= ATT2_COMB && ATT2_LSE + 2048 <= RING_BYTES, "attention LDS (regrouped)");
template <int G, bool FIRST>
__device__ __forceinline__ void att_job2(const bf16* Q, const bf16* Kb, const bf16* Vb, int b, int slot, int sp, int jq, LAS unsigned char* wl, LAS bf16* comb, LAS float* lsea, int lane) {
    constexpr int SH = 2 * G, D = 1 << SH, SG = 8192 >> SH;
    const int c = lane & 31, h = lane >> 5;
    int tl0, ts, rg, u0;
    if (G == 2) { tl0 = jq; ts = 16; rg = jq; u0 = 32 * sp; }
    else if (G == 1) { tl0 = 128 * (jq >> 2) + (jq & 3); ts = 4; rg = jq & 3; u0 = 128 * sp + 32 * (jq >> 2); }
    else { tl0 = 32 * jq; ts = 1; rg = 0; u0 = 512 * sp + 32 * jq; }
    float slope2 = __builtin_amdgcn_exp2f(-8.0f * (float)(4 * G + slot + 1) / 12.0f) * (1.4426950408889634f * (float)D);
    asm volatile("" : "+v"(slope2));
    const int colb = 256 * G + 64 * slot, uq = u0 + c;
    const bf16* qp = Q + ((size_t)b * 8192 + 512 * sp + tl0 + ts * c) * 768 + colb + 8 * h;
    bf16x8 qf[4];
#pragma unroll
    for (int s = 0; s < 4; ++s) qf[s] = *(const bf16x8*)(qp + 16 * s);
    const int n_hi = u0 >> 5; int n_lo = n_hi - 4; if (n_lo < 0) n_lo = 0;
    const size_t kvrow0 = (size_t)b * 8192 + (size_t)rg * SG;
    const LAS unsigned char* vtr0 = wl + (4 * h + ((lane & 15) >> 2)) * VPITCH + (16 * ((lane >> 4) & 1) + 4 * (lane & 3)) * 2;
    const bf16* kbase = Kb + (kvrow0 + c) * 768 + colb + 8 * h;
    const bf16* vbase = Vb + (kvrow0 + (lane >> 1)) * 768 + colb + 32 * (lane & 1);
#define ATT_LOAD(KF, VV, nn) do { const bf16* kp_ = kbase + (size_t)(nn) * (32 * 768); const bf16* vp_ = vbase + (size_t)(nn) * (32 * 768); \
        _Pragma("unroll") for (int s_ = 0; s_ < 4; ++s_) KF[s_] = *(const bf16x8*)(kp_ + 16 * s_); \
        _Pragma("unroll") for (int i_ = 0; i_ < 4; ++i_) VV[i_] = *(const v4u*)(vp_ + 8 * i_); } while (0)
    AttState st; st.m = -1e30f; st.l = 0.f; st.o0 = (f32x16){}; st.o1 = (f32x16){};
    bf16x8 kfA[4], kfB[4]; v4u vvA[4], vvB[4];
    ATT_LOAD(kfA, vvA, n_lo);
    for (int n = n_lo;;) {
        { const int nn = n + 1 < n_hi ? n + 1 : n_hi; ATT_LOAD(kfB, vvB, nn); }
        att_tile(!(n < n_hi && n > n_hi - 4), st, kfA, vvA, qf, n, uq, slope2, wl, vtr0, lane);
        if (n == n_hi) break; ++n;
        { const int nn = n + 1 < n_hi ? n + 1 : n_hi; ATT_LOAD(kfA, vvA, nn); }
        att_tile(!(n < n_hi && n > n_hi - 4), st, kfB, vvB, qf, n, uq, slope2, wl, vtr0, lane);
        if (n == n_hi) break; ++n;
    }
#undef ATT_LOAD
    LAS float* wsf = (LAS float*)(wl + ATT_WSF);
    const float lt = st.l + __shfl_xor(st.l, 32);
    const float lsej = st.m + __builtin_amdgcn_logf(lt);
    const int tlq = tl0 + ts * c;
    if (FIRST) { if (h == 0) { wsf[c] = __builtin_amdgcn_rcpf(lt); lsea[tlq] = lsej; } }
    else if (h == 0) { const float lc = lsea[tlq], M = fmaxf(lc, lsej), wc = __builtin_amdgcn_exp2f(lc - M), wj = __builtin_amdgcn_exp2f(lsej - M), is = __builtin_amdgcn_rcpf(wc + wj);
        wsf[c] = wc * is; wsf[32 + c] = wj * is * __builtin_amdgcn_rcpf(lt); lsea[tlq] = M + __builtin_amdgcn_logf(wc + wj); }
    asm volatile("s_waitcnt lgkmcnt(0)" ::: "memory");
#pragma unroll
    for (int r = 0; r < 16; ++r) { const int q = crow(r, h); LAS bf16* cp = comb + (tl0 + ts * q) * 64 + c;
        if (FIRST) { const float inv = wsf[q]; cp[0] = (bf16)f2bf(st.o0[r] * inv); cp[32] = (bf16)f2bf(st.o1[r] * inv); }
        else { const float wa = wsf[q], wb = wsf[32 + q]; const float c0 = __uint_as_float((unsigned)cp[0] << 16), c1 = __uint_as_float((unsigned)cp[32] << 16);
            cp[0] = (bf16)f2bf(c0 * wa + st.o0[r] * wb); cp[32] = (bf16)f2bf(c1 * wa + st.o1[r] * wb); } }
    asm volatile("s_waitcnt lgkmcnt(0)" ::: "memory");
}
__device__ __forceinline__ void att_unit2(const bf16* Q, const bf16* Kb, const bf16* Vb, bf16* OB, int b, int slot, int sp, LAS unsigned char* lds, int tid) {
    const int lane = tid & 63, wave = __builtin_amdgcn_readfirstlane(tid >> 6);
    LAS unsigned char* wl = lds + wave * ATT2_WAVE_BYTES; LAS bf16* comb = (LAS bf16*)(lds + ATT2_COMB); LAS float* lsea = (LAS float*)(lds + ATT2_LSE);
#pragma unroll 1
    for (int jj = 0; jj < 2; ++jj) att_job2<2, true>(Q, Kb, Vb, b, slot, sp, wave + 8 * jj, wl, comb, lsea, lane);
    __syncthreads();
#pragma unroll 1
    for (int jj = 0; jj < 2; ++jj) att_job2<1, false>(Q, Kb, Vb, b, slot, sp, 4 * (2 * (wave >> 2) + jj) + (wave & 3), wl, comb, lsea, lane);
    __syncthreads();
#pragma unroll 1
    for (int jj = 0; jj < 2; ++jj) att_job2<0, false>(Q, Kb, Vb, b, slot, sp, 2 * wave + jj, wl, comb, lsea, lane);
    __syncthreads();
#pragma unroll
    for (int ps = 0; ps < 8; ++ps) { const int row = ps * 64 + (tid >> 3), ch = tid & 7;
        const v4u v = *(const LAS v4u*)(comb + row * 64 + ch * 8);
        *(v4u*)(OB + ((size_t)b * 8192 + 512 * sp + row) * 768 + 512 + 64 * slot + ch * 8) = v; }
    __syncthreads();
}

constexpr int CONV_ROWS = 94, CONV_CBUF_OFF = 96256;
static_assert(CONV_CBUF_OFF + 32 * 512 * 2 <= RING_BYTES, "conv LDS");
__device__ __forceinline__ void conv_tile(const bf16* U, bf16* CB, const float* w_dw, const float* b_dw, const float* ln_g, const float* ln_b, int b, int t0, LAS unsigned char* lds, int tid) {
    const int lane = tid & 63, wave = tid >> 6;
    LAS bf16* us = (LAS bf16*)lds;
    { v4u stg[12];
#pragma unroll
        for (int k = 0; k < 12; ++k) { const int j = wave + NWAVES * k, t = t0 - 30 + j; stg[k] = (v4u){0u, 0u, 0u, 0u};
            if (j < CONV_ROWS && t >= 0) stg[k] = *(const v4u*)(U + ((size_t)b * 8192 + t) * 512 + lane * 8); }
#pragma unroll
        for (int k = 0; k < 12; ++k) { const int j = wave + NWAVES * k; if (j < CONV_ROWS) *(LAS v4u*)(us + j * 512 + lane * 8) = stg[k]; } }
    __syncthreads();
    const int cp = tid & 255, th = tid >> 8;
    typedef float f2v __attribute__((ext_vector_type(2)));
    f2v wv[31];
    const float* wp = w_dw + 2 * cp; asm volatile("" : "+v"(wp));
#pragma unroll
    for (int k = 0; k < 31; ++k) wv[k] = *(const f2v*)(wp + k * 512);
    const f2v bias = *(const f2v*)(b_dw + 2 * cp);
    LAS bf16* cbuf = (LAS bf16*)(lds + CONV_CBUF_OFF);
#pragma unroll 1
    for (int pass = 0; pass < 2; ++pass) {
        const int tb = th * 32 + pass * 16;
        f2v a[16];
#pragma unroll
        for (int i = 0; i < 16; ++i) a[i] = bias;
#pragma unroll
        for (int j = 0; j < 46; ++j) { const unsigned xv = *(const LAS unsigned*)(us + (tb + j) * 512 + 2 * cp); const f2v x = (f2v){bflo(xv), bfhi(xv)};
#pragma unroll
            for (int i = 0; i < 16; ++i) if (j - i >= 0 && j - i <= 30) a[i] = __builtin_elementwise_fma(wv[j - i], x, a[i]);
            if ((j & 7) == 7) asm volatile("" ::: "memory"); }
#pragma unroll
        for (int i = 0; i < 16; ++i) *(LAS unsigned*)(cbuf + (th * 16 + i) * 512 + 2 * cp) = pk2(a[i].x, a[i].y);
        __syncthreads();
#pragma unroll
        for (int q = 0; q < 4; ++q) { const int rb = 4 * wave + q, tok = (rb >> 4) * 32 + pass * 16 + (rb & 15);
            const v4u w = *(const LAS v4u*)(cbuf + rb * 512 + lane * 8);
            float v[8] = {bflo(w.x), bfhi(w.x), bflo(w.y), bfhi(w.y), bflo(w.z), bfhi(w.z), bflo(w.w), bfhi(w.w)};
            float s1 = 0.f, s2 = 0.f;
#pragma unroll
            for (int e = 0; e < 8; ++e) { s1 += v[e]; s2 += v[e] * v[e]; }
            s1 = wave_sum(s1); s2 = wave_sum(s2);
            const float mean = s1 * (1.f / 512.f), var = s2 * (1.f / 512.f) - mean * mean, rstd = __builtin_amdgcn_rsqf(var + EPS);
            const f32x4 g0 = *(const f32x4*)(ln_g + lane * 8), g1 = *(const f32x4*)(ln_g + lane * 8 + 4), b0 = *(const f32x4*)(ln_b + lane * 8), b1 = *(const f32x4*)(ln_b + lane * 8 + 4);
#pragma unroll
            for (int e = 0; e < 8; ++e) { const float y = (v[e] - mean) * rstd * (e < 4 ? g0[e] : g1[e - 4]) + (e < 4 ? b0[e] : b1[e - 4]); v[e] = y * fsig(y); }
            v4u o; o.x = pk2(v[0], v[1]); o.y = pk2(v[2], v[3]); o.z = pk2(v[4], v[5]); o.w = pk2(v[6], v[7]);
            *(v4u*)(CB + ((size_t)b * 8192 + t0 + tok) * 768 + lane * 8) = o; }
        __syncthreads();
    }
}
__device__ __forceinline__ void conv_sample(const bf16* U, bf16* CB, const float* state, const float* w_dw, const float* b_dw, const float* ln_g, const float* ln_b, int bs, LAS unsigned char* lds, int tid) {
    const int lane = tid & 63, wave = tid >> 6, ch = tid;
    float x[34];
#pragma unroll
    for (int j = 0; j < 30; ++j) x[j] = state[((size_t)bs * 30 + j) * 512 + ch];
#pragma unroll
    for (int j = 0; j < 4; ++j) x[30 + j] = __uint_as_float((unsigned)U[((size_t)MP + bs * 4 + j) * 512 + ch] << 16);
    float a[4]; const float bias = b_dw[ch];
#pragma unroll
    for (int i = 0; i < 4; ++i) a[i] = bias;
#pragma unroll
    for (int k = 0; k < 31; ++k) { const float w = w_dw[k * 512 + ch];
#pragma unroll
        for (int i = 0; i < 4; ++i) a[i] += w * x[i + k]; }
    LAS float* red = (LAS float*)lds;
#pragma unroll
    for (int i = 0; i < 4; ++i) { const float s1 = wave_sum(a[i]), s2 = wave_sum(a[i] * a[i]); if (lane == 0) { red[(i * 8 + wave) * 2] = s1; red[(i * 8 + wave) * 2 + 1] = s2; } }
    __syncthreads();
    const float g = ln_g[ch], be = ln_b[ch];
#pragma unroll
    for (int i = 0; i < 4; ++i) { float s1 = 0.f, s2 = 0.f;
#pragma unroll
        for (int w = 0; w < 8; ++w) { s1 += red[(i * 8 + w) * 2]; s2 += red[(i * 8 + w) * 2 + 1]; }
        const float mean = s1 * (1.f / 512.f), var = s2 * (1.f / 512.f) - mean * mean, rstd = __builtin_amdgcn_rsqf(var + EPS);
        float y = (a[i] - mean) * rstd * g + be; y *= fsig(y);
        CB[((size_t)MP + bs * 4 + i) * 768 + ch] = (bf16)f2bf(y); }
    __syncthreads();
}
__device__ __forceinline__ const float* samp_row(const float* c0, const float* c1, const float* c2, const float* out, int e, int bs, int tok, float& bias2, int slot) {
    const int g = e >= 258 ? 2 : e >= 129 ? 1 : 0, j = e - 129 * g, sh = 2 * g, W = 128 << sh, idx = W + tok - (j << sh);
    const float* cg = (g == 0) ? c0 : (g == 1) ? c1 : c2;
    const float* og = out + ((g == 0) ? O_KV0S : (g == 1) ? O_KV1S : O_KV2S);
    bias2 = __builtin_amdgcn_exp2f(-8.0f * (float)(4 * g + slot + 1) / 12.0f) * 1.4426950408889634f * (float)(j << sh);
    return (idx >= W) ? og + ((size_t)bs * W + (idx - 4)) * 512 + slot * 64 : cg + ((size_t)bs * W + idx) * 512 + slot * 64;
}
__device__ __forceinline__ float row16_sum(float v) { v += DPPF(v, 0xB1); v += DPPF(v, 0x4E); v += DPPF(v, 0x141); v += DPPF(v, 0x140); return v; }
__device__ __forceinline__ void att_sample_wave(const bf16* Q, bf16* OB, const float* c0, const float* c1, const float* c2, const float* out, int bs, int tok, int slot, int lane) {
    const int kq = lane >> 4, i4 = (lane & 15) * 4;
    const size_t qrow = (size_t)MP + bs * 4 + tok;
    f32x4 q4[3];
#pragma unroll
    for (int g = 0; g < 3; ++g) { const uint2 w = *(const uint2*)(Q + qrow * 768 + 256 * g + 64 * slot + i4); q4[g] = (f32x4){bflo(w.x), bfhi(w.x), bflo(w.y), bfhi(w.y)}; }
    float m = -1e30f, l = 0.f; f32x4 acc = (f32x4){0.f, 0.f, 0.f, 0.f};
    f32x4 kvA[8], vvA[8], kvB[8], vvB[8]; float b2A[8], b2B[8];
#define SAMP_LOAD(KV, VV, B2, S0) do { _Pragma("unroll") for (int t = 0; t < 8; ++t) { const int e = 4 * ((S0) + t) + kq, ec = e < 387 ? e : 386; \
            const float* rp = samp_row(c0, c1, c2, out, ec, bs, tok, B2[t], slot) + i4; KV[t] = *(const f32x4*)rp; VV[t] = *(const f32x4*)(rp + 256); } } while (0)
#define SAMP_STEP(KV, VV, B2, S0) do { _Pragma("unroll") for (int t = 0; t < 8; ++t) { const int e = 4 * ((S0) + t) + kq; \
            const f32x4 qq = e >= 258 ? q4[2] : e >= 129 ? q4[1] : q4[0]; \
            const float d = row16_sum((qq[0] * KV[t][0] + qq[1] * KV[t][1]) + (qq[2] * KV[t][2] + qq[3] * KV[t][3])); \
            const float sv = e < 387 ? d - B2[t] : -INFINITY; \
            const float mnew = fmaxf(m, sv), f = __builtin_amdgcn_exp2f(m - mnew), p = __builtin_amdgcn_exp2f(sv - mnew); \
            l = l * f + p; m = mnew; acc = acc * f + VV[t] * p; } } while (0)
    SAMP_LOAD(kvA, vvA, b2A, 0);
#pragma unroll 1
    for (int s0 = 0; s0 < 104; s0 += 16) {
        if (s0 + 8 < 104) SAMP_LOAD(kvB, vvB, b2B, s0 + 8);
        SAMP_STEP(kvA, vvA, b2A, s0);
        if (s0 + 8 >= 104) break;
        if (s0 + 16 < 104) SAMP_LOAD(kvA, vvA, b2A, s0 + 16);
        SAMP_STEP(kvB, vvB, b2B, s0 + 8);
    }
#undef SAMP_LOAD
#undef SAMP_STEP
    float M = fmaxf(m, __shfl_xor(m, 16)); M = fmaxf(M, __shfl_xor(M, 32));
    const float gsc = __builtin_amdgcn_exp2f(m - M);
    l *= gsc; acc = acc * gsc;
    l += __shfl_xor(l, 16); l += __shfl_xor(l, 32);
#pragma unroll
    for (int e = 0; e < 4; ++e) { acc[e] += __shfl_xor(acc[e], 16); acc[e] += __shfl_xor(acc[e], 32); }
    if (kq == 0) { const float inv = __builtin_amdgcn_rcpf(l);
        uint2 w; w.x = pk2(acc[0] * inv, acc[1] * inv); w.y = pk2(acc[2] * inv, acc[3] * inv);
        *(uint2*)(OB + qrow * 768 + 512 + 64 * slot + i4) = w; }
}
__device__ __forceinline__ void sub_barrier(gu32* cnt, unsigned target, bool arrive = true) {
    asm volatile("s_waitcnt vmcnt(0)" ::: "memory");
    __syncthreads();
    if (threadIdx.x == 0) {
        __builtin_amdgcn_fence(__ATOMIC_RELEASE, "agent");
        asm volatile("s_waitcnt vmcnt(0)" ::: "memory");
        if (arrive) __hip_atomic_fetch_add(cnt, 1u, RLX_AGENT);
        unsigned sp = 0;
        while (__hip_atomic_load(cnt, RLX_AGENT) < target) { __builtin_amdgcn_s_sleep(1); if (++sp > (1u << 22)) break; }
        __builtin_amdgcn_fence(__ATOMIC_ACQUIRE, "agent");
        asm volatile("s_waitcnt vmcnt(0)" ::: "memory");
    }
    __syncthreads();
}

__device__ __forceinline__ void kv_copy(const float* cache0, const float* cache1, const float* cache2, const float* state_conv, float* out, unsigned gt, unsigned GS) {
#pragma unroll
    for (int g = 0; g < 3; ++g) {
        const unsigned W = 128u << (2 * g); const float* cg = g == 0 ? cache0 : g == 1 ? cache1 : cache2;
        float* og = out + (g == 0 ? O_KV0S : g == 1 ? O_KV1S : O_KV2S);
        const unsigned per4 = (W - 4) * 128, tot4 = per4 * 32;
        for (unsigned i0 = gt; i0 < tot4; i0 += 8 * GS) {
            f32x4 v[8];
#pragma unroll
            for (int k = 0; k < 8; ++k) { const unsigned i = i0 + k * GS; if (i < tot4) { const unsigned bs = i / per4, r = i - bs * per4;
                v[k] = __builtin_nontemporal_load((const f32x4*)(cg + ((size_t)bs * W + 4) * 512) + r); } }
#pragma unroll
            for (int k = 0; k < 8; ++k) { const unsigned i = i0 + k * GS; if (i < tot4) { const unsigned bs = i / per4, r = i - bs * per4;
                __builtin_nontemporal_store(v[k], (f32x4*)(og + (size_t)bs * W * 512) + r); } }
        }
    }
    const unsigned per4 = 26 * 128, tot4 = per4 * 32;
    for (unsigned i = gt; i < tot4; i += GS) { const unsigned bs = i / per4, r = i - bs * per4;
        ((f32x4*)(out + O_CONVS + (size_t)bs * 30 * 512))[r] = ((const f32x4*)(state_conv + ((size_t)bs * 30 + 4) * 512))[r]; }
}
#define WS_PTRS(ws) \
    float* rstd0 = (float*)(ws + WS_RSTD0); float* ssq1 = (float*)(ws + WS_SSQ1); float* ssq2 = (float*)(ws + WS_SSQ2); float* ssq3 = (float*)(ws + WS_SSQ3); \
    bf16* Wi_t = (bf16*)(ws + WS_W_IN); bf16* Wm_t = (bf16*)(ws + WS_W_C); bf16* Wo_t = (bf16*)(ws + WS_W_O); \
    bf16* Wu_t = (bf16*)(ws + WS_W_UP); bf16* Wd_t = (bf16*)(ws + WS_W_DN); bf16* Wg_t = (bf16*)(ws + WS_W_PG); bf16* Wp_t = (bf16*)(ws + WS_W_PL); \
    bf16* PB = (bf16*)(ws + WS_PB); bf16* XB = (bf16*)(ws + WS_XB); bf16* CO = (bf16*)(ws + WS_CO); \
    bf16* U = (bf16*)(ws + WS_U); bf16* Qb = (bf16*)(ws + WS_Q); bf16* Kb = (bf16*)(ws + WS_K); bf16* Vb = (bf16*)(ws + WS_V); \
    bf16* MIX = (bf16*)(ws + WS_MIX); bf16* HB = (bf16*)(ws + WS_H); bf16* GT = (bf16*)(ws + WS_GT); bf16* PP = (bf16*)(ws + WS_PP);
__global__ void __launch_bounds__(NTHREADS, 2) mega_fwd(Args args) {
    extern __shared__ __attribute__((aligned(16))) unsigned char lds_raw[];
    LAS unsigned char* lds = (LAS unsigned char*)lds_raw;
    volatile LAS unsigned* MISC = (volatile LAS unsigned*)(lds + MISC_OFF);
    const int tid0 = threadIdx.x; const int wave0 = __builtin_amdgcn_readfirstlane(tid0 >> 6);
    const int G = gridDim.x; const int bx = blockIdx.x; const int vcu = (G % 8 == 0) ? (bx % 8) * (G / 8) + bx / 8 : bx;
    unsigned char* ws = args.ws; float* out = args.out;
    gu32* ctl = (gu32*)(ws + WS_CTL);
    const float* x_prompt = args.in[0]; const float* x_sample = args.in[1]; const float* state_conv = args.in[2];
    const float* cache0 = args.in[3]; const float* cache1 = args.in[4]; const float* cache2 = args.in[5];
    const float* p_prompt = args.in[6]; const float* p_sample = args.in[7];
    const float* g_mix = args.in[8]; const float* w_in = args.in[9]; const float* w_dw = args.in[10]; const float* b_dw = args.in[11];
    const float* ln_g = args.in[12]; const float* ln_b = args.in[13]; const float* w_conv_out = args.in[14]; const float* w_att_out = args.in[15];
    const float* w_out = args.in[16]; const float* g_ffn = args.in[17]; const float* w_ffn_gate = args.in[18]; const float* w_ffn_up = args.in[19];
    const float* w_ffn_down = args.in[20]; const float* g_ple = args.in[21]; const float* w_ple_gate = args.in[22]; const float* w_ple = args.in[23];
    const float* g_final = args.in[24];
    for (int u = tid0; u < (LDS_BYTES - LDSCTL_OFF) / 4; u += NTHREADS) ((LAS unsigned*)(lds + LDSCTL_OFF))[u] = 0u;
    __syncthreads();
    XcdBarrier bar; bar.bar = (unsigned*)(ctl + CW_BAR); bar.x = 0; bar.st = nullptr; bar.gsize = 0u;
    if (N_LAUNCHES == 1) bar = xcd_barrier_post((unsigned*)(ctl + CW_BAR), MISC + 8);
    XcdBarrier gbar = xcd_barrier_post((unsigned*)(ctl + CW_GBAR) + (blockIdx.x & 15) * XCD_BAR_WORDS, MISC + 12); gbar.gsize = gridDim.x / 16;
    const bool is_smp = blockIdx.x < 32;
    XcdBarrier rbar = xcd_barrier_post((unsigned*)(ctl + (is_smp ? CW_SBAR : CW_PBAR)), MISC + 16); rbar.gsize = is_smp ? 32u : gridDim.x - 32u;
#define ROLE_BAR() do { XcdBarrier b4_ = rbar; asm volatile("" : "+s"(b4_.bar)); xcd_barrier(b4_); } while (0)
#define GROUP_BAR() do { XcdBarrier b3_ = gbar; asm volatile("" : "+s"(b3_.bar)); xcd_barrier(b3_); } while (0)
#define GRID_BAR() do { if (N_LAUNCHES == 1) { XcdBarrier b2_ = bar; asm volatile("" : "+s"(b2_.bar)); xcd_barrier(b2_); } } while (0)
    const int lo = args.ph_lo, hi = args.ph_hi;
#ifdef PROBE_TS
    unsigned long long* tsw = (unsigned long long*)(ctl + 12288); int nstamp = 0;
#ifndef TS_BLOCK
#define TS_BLOCK 0
#endif
#define STAMP() do { if (bx == TS_BLOCK && wave0 == 0 && __builtin_amdgcn_mbcnt_hi(~0u, __builtin_amdgcn_mbcnt_lo(~0u, 0u)) == 0) tsw[nstamp] = __builtin_amdgcn_s_memrealtime(); ++nstamp; } while (0)
#else
#define STAMP() do {} while (0)
#endif
    STAMP();
#ifndef PH_MASK
#define PH_MASK 0x1ff
#endif
#define IN(k) ((((PH_MASK) >> (k)) & 1) && lo <= (k) && (k) < hi)
#define BOTH(k) (IN(k) && IN((k) + 1))
#ifndef PROBE_DBL
#define PROBE_DBL 0
#endif
#ifndef ATT_REP
#define ATT_REP 1
#endif
#ifndef CONV_REP
#define CONV_REP 1
#endif
#ifndef SAMP_REP
#define SAMP_REP 1
#endif
#ifndef W_REP
#define W_REP 1
#endif
#ifndef ROW_REP
#define ROW_REP 1
#endif
#ifndef COPY_REP
#define COPY_REP 1
#endif
#ifndef PPB_PANELS
#define PPB_PANELS 64
#endif
#ifndef SKIP_MASK
#define SKIP_MASK 0
#endif
#define NREP(k) ((((PROBE_DBL) >> (k)) & 1) ? 2 : 1)
    const int NGW = G * NWAVES; constexpr int NSWG = 32, CW_GRP = 8448, CW_SB = 8192, CW_PG = 8320, CW_Q = 8384, CW_TMO2 = 8256, CW_PCNT = 16384, LASTPH = 7;
#define PH_IDS() unsigned z_ = 0u; asm volatile("" : "+s"(z_)); int tid_ = wave0 * 64 + (int)__builtin_amdgcn_mbcnt_hi(~0u, __builtin_amdgcn_mbcnt_lo(~0u, z_)); asm volatile("" : "+v"(tid_)); const int tid = tid_, lane = tid & 63, wave = __builtin_amdgcn_readfirstlane(tid >> 6), gw = vcu * NWAVES + wave; (void)lane; (void)gw

    constexpr int I_IN = 16 * (NIN / 32), I_C = 8 * 32, I_A = 4 * 32, I_O = 16 * 32, I_U = 16 * (2 * DFF / 32), I_D = (DFF / 64) * 32, I_G = 16 * 32, I_P = 4 * 32;
    constexpr int NITEMS = I_IN + I_C + I_A + I_O + I_U + I_D + I_G + I_P;
#define W_ITEM(it_) do { int r = (it_); \
        if (r < I_IN) { const int nblk = NIN / 32, kb = r / nblk, nb = r % nblk, R = 32 * nb, pn = R >> 8, cc = R & 255; \
            const int csrc = pn < 4 ? (cc < 128 ? 128 * pn + cc : 512 + 128 * pn + (cc - 128)) : pn < 13 ? R : (cc < 128 ? 3328 + 128 * (pn - 13) + cc : 4352 + 128 * (pn - 13) + (cc - 128));   \
            p0_transpose_item(w_in, NIN, 64 * kb, csrc, Wi_t, 1024, R, g_mix, scr, lane); } \
        else if ((r -= I_IN) < I_C) { p0_mat_item(w_conv_out, 512, 1024, 0, 1024, Wm_t, 768, 0, nullptr, scr, r, lane); } \
        else if ((r -= I_C) < I_A) { p0_mat_item(w_att_out, 256, 1024, 0, 1024, Wm_t, 768, 0, nullptr, scr, r, lane, 512); } \
        else if ((r -= I_A) < I_O) { p0_mat_item(w_out, 1024, 1024, 0, 1024, Wo_t, 1024, 0, nullptr, scr, r, lane); } \
        else if ((r -= I_O) < I_U) { const int nblk = 2 * DFF / 32, kb = r / nblk, nb = r % nblk, R = 32 * nb, pn = R >> 8, cc = R & 255; \
            const float* src = cc < 128 ? w_ffn_gate : w_ffn_up; const int csrc = 128 * pn + (cc & 127); \
            p0_transpose_item(src, DFF, 64 * kb, csrc, Wu_t, 1024, R, g_ffn, scr, lane); } \
        else if ((r -= I_U) < I_D) { p0_mat_item(w_ffn_down, DFF, 1024, 0, 1024, Wd_t, DFF, 0, nullptr, scr, r, lane); } \
        else if ((r -= I_D) < I_G) { p0_mat_item(w_ple_gate, 1024, 1024, 0, 1024, Wg_t, 1024, 0, g_ple, scr, r, lane); } \
        else { r -= I_G; p0_mat_item(w_ple, 256, 1024, 0, 1024, Wp_t, 256, 0, nullptr, scr, r, lane); } } while (0)
    if (IN(0)) for (int rep_ = 0; rep_ < NREP(0); ++rep_) {
        PH_IDS();
        unsigned char* wsl = ws; asm volatile("" : "+s"(wsl)); WS_PTRS(wsl)
        LAS float* scr = (LAS float*)(lds + wave * 16384);
        for (int j = gw; j < I_IN + I_P; j += NGW) { W_ITEM(j < I_IN ? j : (NITEMS - I_P) + (j - I_IN)); }
        for (int r2_ = 0; r2_ < ROW_REP; ++r2_)
        for (int m = gw; m < MPAD; m += NGW) {
            GAS unsigned long long* xo = (GAS unsigned long long*)(XB + (size_t)m * 1024) + lane;
            GAS unsigned long long* po = (GAS unsigned long long*)(PB + (size_t)m * 256) + lane;
            if (m < MR) {
                const float* xr = m < MP ? x_prompt + (size_t)m * 1024 : x_sample + (size_t)(m - MP) * 1024;
                const float* pr = m < MP ? p_prompt + (size_t)m * 256 : p_sample + (size_t)(m - MP) * 256;
                f32x4 v[4]; float s = 0.f;
#pragma unroll
                for (int j = 0; j < 4; ++j) { v[j] = ((const GAS f32x4*)xr)[lane + 64 * j]; s += (v[j][0] * v[j][0] + v[j][1] * v[j][1]) + (v[j][2] * v[j][2] + v[j][3] * v[j][3]); }
                const f32x4 pv = ((const GAS f32x4*)pr)[lane];
                s = wave_sum(s);
                if (lane == 0) rstd0[m] = __builtin_amdgcn_rsqf(s * (1.f / 1024.f) + EPS);
#pragma unroll
                for (int j = 0; j < 4; ++j) xo[64 * j] = (unsigned long long)pk2(v[j][0], v[j][1]) | ((unsigned long long)pk2(v[j][2], v[j][3]) << 32);
                po[0] = (unsigned long long)pk2(pv[0], pv[1]) | ((unsigned long long)pk2(pv[2], pv[3]) << 32);
            } else {
                if (lane == 0) rstd0[m] = 0.f;
#pragma unroll
                for (int j = 0; j < 4; ++j) xo[64 * j] = 0ull;
                po[0] = 0ull;
            }
        }
        if (BOTH(0) || rep_ + 1 < NREP(0)) GRID_BAR();
    }
    STAMP();

    enum { MODE_S = 0, MODE_PS = 1, MODE_ALL = 2, MODE_GA = 3, MODE_GB = 4 };
    const int grp = (bx >> 3) & 1, cg = bx >> 4; unsigned ggen = 0;
    int mode = (bx < NSWG) ? MODE_S : MODE_PS, phase = (bx < NSWG) ? 0 : 1; unsigned sbgen = 0; bool rep_done = false;
    gu32* sbcnt = ctl + CW_SB;
#ifdef PROBE_TS2
    if (bx == 0 && wave0 == 0 && __builtin_amdgcn_mbcnt_hi(~0u, __builtin_amdgcn_mbcnt_lo(~0u, 0u)) == 0) ((unsigned long long*)(ctl + 12288))[32] = __builtin_amdgcn_s_memrealtime();
#endif
    for (;;) {
        unsigned char* wsl = ws; asm volatile("" : "+s"(wsl)); WS_PTRS(wsl)
        int pm0, nMt, Gm, cm, vcm;
        bf16 *COm = CO, *MIXm = MIX, *HBm = HB;
        if (mode == MODE_S) { pm0 = MP / 256; nMt = 1; Gm = NSWG; cm = bx; vcm = bx;
            COm = (bf16*)(wsl + WS_SMP_CO) - (size_t)MP * 768; MIXm = (bf16*)(wsl + WS_SMP_MIX) - (size_t)MP * 1024;
            HBm = (bf16*)(wsl + WS_SMP_H) - (size_t)MP * DFF; }
        else if (mode == MODE_PS) { pm0 = 0; nMt = MP / 256; Gm = G - NSWG; cm = bx - NSWG; vcm = cm; }
        else if (mode == MODE_ALL) { pm0 = 0; nMt = MP / 256; Gm = G; cm = bx; vcm = vcu; }
        else { pm0 = 8 * (bx & 7) + ((mode == MODE_GB) ? 64 : 0); nMt = 8; Gm = G / 16; cm = cg; vcm = cg; }
        const bool p4 = (mode == MODE_GA || mode == MODE_GB);
        const int ph = (phase == 3 && ((mode == MODE_PS) || (mode == MODE_S && cm >= 4 && cm < 8))) ? 8 : (mode == MODE_S && ((phase == 3 && cm >= 8) || (phase == 4 && cm >= 4))) ? 9 : phase;
        switch (ph) {
        case 0: {
            PH_IDS(); LAS float* scr = (LAS float*)(lds + wave * 16384);
            for (int j = I_IN + cm * NWAVES + wave; j < I_IN + I_C + I_A; j += NSWG * NWAVES) { W_ITEM(j); }
        } break;
        case 9: {
            PH_IDS(); LAS float* scr = (LAS float*)(lds + wave * 16384);
            const int w0 = (phase == 3) ? 8 : 4, jlo = (phase == 3) ? I_IN + I_C + I_A : I_IN + I_C + I_A + I_O + I_U, jhi = (phase == 3) ? I_IN + I_C + I_A + I_O + I_U : NITEMS - I_P;
            for (int j = jlo + (cm - w0) * NWAVES + wave; j < jhi; j += (NSWG - w0) * NWAVES) { W_ITEM(j); }
        } break;
        case 1: if (!((SKIP_MASK >> 1) & 1)) {
            pg8::Gemm g{XB, Wi_t, MPAD, NIN, 1024, 1024}; pg8::RangeOrder S; S.init(pm0, nMt, NIN, Gm, cm);
            pg8::EpiIn E{rstd0, U, Qb, Kb, Vb, GT, out};
            pg8::gemm_phase<pg8::EpiIn, pg8::RangeOrder, true, true>(lds, g, S, E, wave0);
        } break;
        case 2: if (!((SKIP_MASK >> 2) & 1)) {
            PH_IDS();
            if (mode == MODE_S) {
                conv_sample(U, COm, state_conv, w_dw, b_dw, ln_g, ln_b, cm, lds, tid);
#pragma unroll 1
                for (int r = 0; r < 2; ++r) { const int j = cm * 16 + r * 8 + wave;
#ifndef NO_SAMPATT
                    att_sample_wave(Qb, COm, cache0, cache1, cache2, out, j >> 4, (j >> 2) & 3, j & 3, lane);
#endif
                }
            } else {
                LAS int* qit = (LAS int*)(lds + LDSCTL_OFF + 64);
                constexpr int CW_QX = 9216, QN = 96; int tries = 0;
                for (;;) {
                    __syncthreads();
                    if (tid == 0) { int v = -1, t = tries;
                        for (; t < 8; ++t) { const int y = (bx + t) & 7; const unsigned got = __hip_atomic_fetch_add(ctl + CW_QX + 64 * y, 1u, RLX_AGENT); if (got < (unsigned)QN) { v = y * QN + (int)got; break; } }
                        qit[0] = v; qit[1] = t; }
                    __syncthreads();
                    const int it = __builtin_amdgcn_readfirstlane(qit[0]); tries = __builtin_amdgcn_readfirstlane(qit[1]);
                    if (it < 0) break;
                    const int qy = it / QN, qk = it - qy * QN;
                    unsigned zq_ = 0u; asm volatile("" : "+s"(zq_)); int tq = wave0 * 64 + (int)__builtin_amdgcn_mbcnt_hi(~0u, __builtin_amdgcn_mbcnt_lo(~0u, zq_)); asm volatile("" : "+v"(tq));
                    if (qk < 32) {
                        int pr_, sp_; if (qk < 30) { const int h_ = qk >= 15 ? 1 : 0; pr_ = 2 * qy + h_; sp_ = 1 + (qk - 15 * h_); } else { pr_ = 2 * qy + (qk - 30); sp_ = 0; }
                        att_unit2(Qb, Kb, Vb, COm, pr_ >> 2, pr_ & 3, sp_, lds, tq); }
                    else { const int ti = 64 * qy + (qk - 32); conv_tile(U, COm, w_dw, b_dw, ln_g, ln_b, ti >> 7, (ti & 127) * 64, lds, tq); }
                }
            }
        } break;
        case 3: if (!((SKIP_MASK >> 3) & 1)) {
            int k3 = 768; asm volatile("" : "+s"(k3));
            pg8::Gemm g{COm, Wm_t, MPAD, 1024, k3, k3}; pg8::RangeOrder S; S.init(pm0, nMt, 1024, Gm, cm, p4); pg8::EpiMix E{GT, MIXm};
            pg8::gemm_phase<pg8::EpiMix, pg8::RangeOrder, true, true>(lds, g, S, E, wave0);
        } break;
        case 8: {
            int k8 = 256; asm volatile("" : "+s"(k8));
            pg8::Gemm g{PB, Wp_t, MPAD, 1024, k8, k8}; pg8::RangeOrder S; S.init(pm0, mode == MODE_PS ? 64 : nMt, 1024, mode == MODE_S ? 4 : Gm, mode == MODE_S ? cm - 4 : cm, p4); pg8::EpiGate E{nullptr, 0, PP};
            pg8::gemm_phase<pg8::EpiGate, pg8::RangeOrder, true, true>(lds, g, S, E, wave0);
        } break;
        case 4: if (!((SKIP_MASK >> 4) & 1)) {
            pg8::Gemm g{MIXm, Wo_t, MPAD, 1024, 1024, 1024}; pg8::RangeOrder S; S.init(pm0, nMt, 1024, Gm, cm, p4); pg8::EpiResidIn E{x_prompt, x_sample, XB, ssq1};
            pg8::gemm_phase<pg8::EpiResidIn, pg8::RangeOrder, true, true>(lds, g, S, E, wave0);
        } break;
        case 5: if (!((SKIP_MASK >> 5) & 1)) {
            pg8::Gemm g{XB, Wu_t, MPAD, 2 * DFF, 1024, 1024}; pg8::RangeOrder S; S.init(pm0, nMt, 2 * DFF, Gm, cm, p4); pg8::EpiUp E{ssq1, HBm, cache0, cache1, cache2, state_conv, out};
            pg8::gemm_phase<pg8::EpiUp, pg8::RangeOrder, true, true>(lds, g, S, E, wave0);
#ifdef PROBE_NULLEPI
            if (mode == MODE_ALL) { GRID_BAR(); pg8::EpiNull E0{}; pg8::gemm_phase<pg8::EpiNull, pg8::RangeOrder, true, true>(lds, g, S, E0, wave0); }
#endif
        } break;
        case 6: if (!((SKIP_MASK >> 6) & 1)) {
            pg8::Gemm g{HBm, Wd_t, MPAD, 1024, DFF, DFF}; pg8::RangeOrder S; S.init(pm0, nMt, 1024, Gm, cm, p4); pg8::EpiResidB E{XB, ssq2};
            pg8::gemm_phase<pg8::EpiResidB, pg8::RangeOrder, true, true>(lds, g, S, E, wave0);
        } break;
        case 7: if (!((SKIP_MASK >> 7) & 1)) {
            { pg8::Gemm g{XB, Wg_t, MPAD, 1024, 1024, 1024}; pg8::RangeOrder S; S.init(pm0, nMt, 1024, Gm, cm, p4); pg8::EpiPleNorm E{ssq2, PP, XB, out, ssq3, (unsigned*)(ctl + CW_PCNT), g_final, (unsigned*)(ctl + CW_TMO2), (LAS float*)(lds + LDSCTL_OFF + 4096)};
              pg8::gemm_phase<pg8::EpiPleNorm, pg8::RangeOrder, true, true>(lds, g, S, E, wave0); }
        } break;
        default: break;
        }
#ifdef PROBE_TS2
        { const bool l0 = wave0 == 0 && __builtin_amdgcn_mbcnt_hi(~0u, __builtin_amdgcn_mbcnt_lo(~0u, 0u)) == 0; unsigned long long* t2 = (unsigned long long*)(ctl + 12288) + 32;
          asm volatile("s_waitcnt vmcnt(0)" ::: "memory");
          if (l0 && bx == 0 && mode == MODE_S) t2[phase] = __builtin_amdgcn_s_memrealtime();
          if (l0 && bx == 32 && mode == MODE_PS) t2[phase == 1 ? 8 : 9] = __builtin_amdgcn_s_memrealtime(); }
#endif
        if (mode == MODE_ALL) {
            STAMP(); GRID_BAR(); STAMP();
            if (grp) { mode = MODE_GB; phase = 8; } else { mode = MODE_GA; phase = 3; }
        } else if (mode == MODE_GA || mode == MODE_GB) {
            if (phase == 8) { phase = 3; continue; }
            if (phase == LASTPH) break;
            STAMP(); GROUP_BAR(); STAMP(); ++phase;
        } else if (mode == MODE_S) {
            if (phase == LASTPH) { sub_barrier(ctl + CW_PFLAG, 1u, false); STAMP(); mode = MODE_ALL; phase = 2; }
            else if (phase == 0) { __syncthreads(); phase = 1; continue; }
            else if (phase >= 6) { ++sbgen; sub_barrier(sbcnt, sbgen * 4u); ++phase; }
            else { ROLE_BAR();
                if (phase == 5 && cm >= 4) { sub_barrier(ctl + CW_PFLAG, 1u, false); STAMP(); mode = MODE_ALL; phase = 2; continue; }
#ifdef CHAIN_DBL
                if (((CHAIN_DBL >> phase) & 1) && !rep_done) { rep_done = true; continue; }
                rep_done = false;
#endif
                ++phase; }
        } else {
            if (phase == 1) { phase = 3; continue; }
            ROLE_BAR();
            if (cm == 0 && wave0 == 0 && __builtin_amdgcn_mbcnt_hi(~0u, __builtin_amdgcn_mbcnt_lo(~0u, 0u)) == 0) __hip_atomic_store(ctl + CW_PFLAG, 1u, RLX_AGENT);
            STAMP(); mode = MODE_ALL; phase = 2; }
    }
#ifdef PROBE_TS2
    GRID_BAR();
    if (bx == 0 && wave0 == 0 && __builtin_amdgcn_mbcnt_hi(~0u, __builtin_amdgcn_mbcnt_lo(~0u, 0u)) == 0) { unsigned long long* t2 = (unsigned long long*)(ctl + 12288) + 32; out[0] += (float)(((unsigned)(t2[PROBE_TS2] - t2[0]) + 500u) / 1000u) * 10.0f; }
#endif
#ifdef PROBE_TS
    GRID_BAR(); STAMP();
    if (bx == 0 && wave0 == 0 && __builtin_amdgcn_mbcnt_hi(~0u, __builtin_amdgcn_mbcnt_lo(~0u, 0u)) == 0) {
        unsigned long long d = tsw[PROBE_TS] - tsw[PROBE_TS - 1];
#ifdef PROBE_Q
        d = tsw[PROBE_Q];
#endif
#ifdef PROBE_TSUM
        d = 0; for (int k_ = 0; k_ < PROBE_TSUM; ++k_) d += tsw[PROBE_TS + 2 * k_] - tsw[PROBE_TS + 2 * k_ - 1];
#endif
        #ifndef PROBE_QUANT
#define PROBE_QUANT 500u
#endif
        out[0] += (float)(((unsigned)d + PROBE_QUANT / 2) / PROBE_QUANT) * (float)(PROBE_QUANT / 100u); }
#endif
#undef IN
#undef BOTH
#undef GRID_BAR
}

extern "C" void kernel_launch(void* const* d_in, const int* in_sizes, int n_in, void* d_out, int out_size, void* d_ws, size_t ws_size, hipStream_t stream) {
    static int grid = 0;
    if (grid == 0) {
        if (n_in != 25 || (size_t)out_size != O_END || ws_size < WS_END) { fprintf(stderr, "kernel_launch: shape mismatch: n_in %d out %d ws %zu (need %zu)\n", n_in, out_size, ws_size, (size_t)WS_END); grid = -1; return; }
        int dev = 0, cus = 0;
        if (hipGetDevice(&dev) != hipSuccess || hipDeviceGetAttribute(&cus, hipDeviceAttributeMultiprocessorCount, dev) != hipSuccess) { grid = -1; return; }
        if (hipFuncSetAttribute((const void*)mega_fwd, hipFuncAttributeMaxDynamicSharedMemorySize, LDS_BYTES) != hipSuccess) { fprintf(stderr, "kernel_launch: hipFuncSetAttribute failed\n"); grid = -1; return; }
        int per_cu = 0;
        if (hipOccupancyMaxActiveBlocksPerMultiprocessor(&per_cu, (const void*)mega_fwd, NTHREADS, LDS_BYTES) != hipSuccess || per_cu < 1) fprintf(stderr, "kernel_launch: occupancy query says %d\n", per_cu);
        (void)hipGetLastError();
        grid = cus;
    }
    if (grid < 0) return;
    (void)hipMemsetAsync((char*)d_ws + WS_CTL, 0, CTL_ZERO_BYTES, stream);
    Args a{};
    for (int i = 0; i < 25; ++i) a.in[i] = (const float*)d_in[i];
    a.out = (float*)d_out; a.ws = (unsigned char*)d_ws;
    if (N_LAUNCHES == 1) { a.ph_lo = 0; a.ph_hi = NPHASE; if (grid != 256) { fprintf(stderr, "kernel_launch: built for 256 CUs, got %d\n", grid); return; } hipLaunchKernelGGL(mega_fwd, dim3(grid), dim3(NTHREADS), LDS_BYTES, stream, a); }
    else {
#ifdef DBG_DUMP
        for (int li = 0; li <= DBG_DUMP; ++li) { a.ph_lo = li; a.ph_hi = li + 1; hipLaunchKernelGGL(mega_fwd, dim3(grid), dim3(NTHREADS), LDS_BYTES, stream, a); }
        if (DBG_DUMP == 1 || DBG_DUMP == 2 || DBG_DUMP == 3 || DBG_DUMP == 5) { a.ph_lo = 9; a.ph_hi = 10; hipLaunchKernelGGL(mega_fwd, dim3(grid), dim3(NTHREADS), LDS_BYTES, stream, a); }
#else
        for (int li = 0; li < NPHASE; ++li) { a.ph_lo = li; a.ph_hi = li + 1; hipLaunchKernelGGL(mega_fwd, dim3(grid), dim3(NTHREADS), LDS_BYTES, stream, a); }
#endif
    }
}
```

```cpp
#include <hip/hip_runtime.h>
#include <cstdio>
#include <cstdint>

namespace cfg {
constexpr int DM = 1024, SEQ = 8192, NBATCH = 4, MP = NBATCH * SEQ, NSEQ = 32, NTOK = 4, MS = NSEQ * NTOK, MR = MP + MS, MPAD = 33024;
constexpr int DCONV = 512, NIN = 5376, DFF = 2816, DPLE = 256, CWID = 31;
constexpr float EPS = 1e-6f;
constexpr float C2 = 0.125f * 1.4426950408889634f;
constexpr size_t O_Y = 0;
constexpr size_t O_CONVP = (size_t)MR * DM;
constexpr size_t O_CONVS = O_CONVP + (size_t)4 * 30 * 512;
constexpr size_t O_KV0P = O_CONVS + (size_t)32 * 30 * 512;
constexpr size_t O_KV0S = O_KV0P + (size_t)4 * 128 * 512;
constexpr size_t O_KV1P = O_KV0S + (size_t)32 * 128 * 512;
constexpr size_t O_KV1S = O_KV1P + (size_t)4 * 512 * 512;
constexpr size_t O_KV2P = O_KV1S + (size_t)32 * 512 * 512;
constexpr size_t O_KV2S = O_KV2P + (size_t)4 * 2048 * 512;
constexpr size_t O_END = O_KV2S + (size_t)32 * 2048 * 512;
static_assert(O_END == 83783680, "output size");
}
namespace pg8 {
#define PG8_LAS __attribute__((address_space(3)))
typedef unsigned short bf16_t;
typedef short bf16x8 __attribute__((ext_vector_type(8)));
typedef float f32x4 __attribute__((ext_vector_type(4)));
typedef unsigned u32x4 __attribute__((ext_vector_type(4)));
constexpr int BM = 256, BK = 64, HALF = 128, HTB = HALF * BK * 2  , STAGE_BYTES = 8 * HTB, NXCD = 8, WGM = 4;

__host__ __device__ __forceinline__ int lds_byte(int r, int c) { const int st = (r >> 4) * 2 + (c >> 5), rr = r & 15, cc = c & 31, ob = rr * 64 + cc * 2; return st * 1024 + (ob ^ (((ob >> 9) & 1) << 5)); }
__host__ __device__ __forceinline__ void stage_rc(int b, int& R, int& C) { const int st = b / 1024, sb = b % 1024, swz = sb ^ (((sb >> 9) & 1) << 5); R = (st >> 1) * 16 + swz / 64; C = (st & 1) * 32 + (swz % 64) / 2; }
__host__ __device__ __forceinline__ int perm32(int rho) { const int n = rho >> 4, i = rho & 15; return 8 * (i >> 2) + 4 * n + (i & 3); }

struct Unit { int pm, pn; };
struct Gemm { const bf16_t* A; const bf16_t* Bt; int M, N, K, ld; };

struct StaticOrder {
    int nM, nN, nwg, G, c;
    __host__ __device__ void init(int M, int N, int G_, int c_) { nM = M / BM; nN = N / BM; nwg = nM * nN; G = G_; c = c_; }
    __host__ __device__ bool next(int i, Unit& u) const {
        const long L = (long)i * G + c; if (L >= nwg) return false;
        int wgid = (int)L; { const int q = nwg / NXCD, r = nwg % NXCD, xcd = wgid % NXCD, off = wgid / NXCD; wgid = (xcd < r ? xcd * (q + 1) : r * (q + 1) + (xcd - r) * q) + off; }
        const int nig = WGM * nN, gid = wgid / nig, fm = gid * WGM, gsz = (nM - fm) < WGM ? (nM - fm) : WGM;
        u.pm = fm + ((wgid % nig) % gsz); u.pn = (wgid % nig) / gsz; return true;
    }
    __device__ __forceinline__ void a_ready(const Unit&) const {}
    __device__ __forceinline__ void done(const Unit&) const {}
};

typedef float f32x2c_t __attribute__((ext_vector_type(2))); typedef __bf16 bf16x2c_t __attribute__((ext_vector_type(2)));
__device__ __forceinline__ unsigned cvt_pk_bf16(float lo, float hi) { const f32x2c_t v = {lo, hi}; const bf16x2c_t b = __builtin_convertvector(v, bf16x2c_t); return __builtin_bit_cast(unsigned, b); }
typedef float f32x2 __attribute__((ext_vector_type(2)));
__device__ __forceinline__ float sigm(float x) { return __builtin_amdgcn_rcpf(1.0f + __builtin_amdgcn_exp2f(-1.4426950408889634f * x)); }
__device__ __forceinline__ u32x4 pack8(const f32x4 a, const f32x4 b) { u32x4 w; w.x = cvt_pk_bf16(a[0], a[1]); w.y = cvt_pk_bf16(a[2], a[3]); w.z = cvt_pk_bf16(b[0], b[1]); w.w = cvt_pk_bf16(b[2], b[3]); return w; }
__device__ __forceinline__ void unpack8(const u32x4 w, f32x4& a, f32x4& b) {
    a[0] = __uint_as_float(w.x << 16); a[1] = __uint_as_float(w.x & 0xffff0000u); a[2] = __uint_as_float(w.y << 16); a[3] = __uint_as_float(w.y & 0xffff0000u);
    b[0] = __uint_as_float(w.z << 16); b[1] = __uint_as_float(w.z & 0xffff0000u); b[2] = __uint_as_float(w.w << 16); b[3] = __uint_as_float(w.w & 0xffff0000u); }
__device__ __forceinline__ float dot4(const f32x4 a) { return (a[0] * a[0] + a[1] * a[1]) + (a[2] * a[2] + a[3] * a[3]); }
__device__ __forceinline__ float rstd16(const float* p) {
    const f32x4 a = *(const f32x4*)p, b = *(const f32x4*)(p + 4), c = *(const f32x4*)(p + 8), d = *(const f32x4*)(p + 12);
    const float s = (((a[0] + a[1]) + (a[2] + a[3])) + ((b[0] + b[1]) + (b[2] + b[3]))) + (((c[0] + c[1]) + (c[2] + c[3])) + ((d[0] + d[1]) + (d[2] + d[3])));
    return __builtin_amdgcn_rsqf(s * (1.0f / 1024.0f) + cfg::EPS);
}

struct RangeOrder : StaticOrder {
    int pm0; bool g16;
    __device__ __forceinline__ void init(int pm0_, int nMt, int N, int G_, int c_, bool g16_ = false) { StaticOrder::init(nMt * BM, N, G_, c_); pm0 = pm0_; g16 = g16_; }
    __device__ __forceinline__ bool next(int i, Unit& u) const {
        if (g16) { if (i * 16 + c >= nwg) return false; if (nN == 4) { u.pm = pm0 + 4 * i + (c & 3); u.pn = c >> 2; } else if (i < 10) { const int hs = i >= 5 ? 1 : 0, j = i - 5 * hs; u.pm = pm0 + 4 * hs + (c & 3); u.pn = 4 * j + (c >> 2); } else { u.pm = pm0 + (c & 7); u.pn = 20 + (c >> 3); } return true; }
        if (!StaticOrder::next(i, u)) return false; u.pm += pm0; return true; }
};

struct EpiIn {
    static constexpr bool PERM = true, AFTER_DRAIN = false, DRAINS = true; static constexpr int MID_T = 0;
    const float* rstd; bf16_t *U, *Q, *Kb, *Vb, *GT; float* out;
    __device__ __forceinline__ void operator()(const f32x4 (&acc)[2][2][4][2], const Unit& u, int wr, int wc, int fr, int fq) const {
        using namespace cfg;
        const int pn = u.pn, rbase = u.pm * BM + wr * 64 + fr, cl = wc * 32 + 8 * fq, tb = u.pm & 31;
        const bool smp = (u.pm == MP / BM);
        if (pn < 4) {
            const bool hasout = smp || tb == 31;
#pragma unroll
            for (int ai = 0; ai < 2; ++ai)
#pragma unroll
                for (int m = 0; m < 4; ++m) {
                    const int row = rbase + ai * HALF + m * 16; const float rs = rstd[row];
                    f32x4 a0 = acc[ai][0][m][0] * rs, a1 = acc[ai][0][m][1] * rs; const f32x4 b0 = acc[ai][1][m][0] * rs, b1 = acc[ai][1][m][1] * rs;
#pragma unroll
                    for (int e = 0; e < 4; ++e) { a0[e] *= sigm(b0[e]); a1[e] *= sigm(b1[e]); }
                    *(u32x4*)(U + (size_t)row * 512 + pn * 128 + cl) = pack8(a0, a1);
                    if (hasout) {
                        float* dst = nullptr;
                        if (!smp) { const int t = row & 8191; if (t >= 8162) dst = out + O_CONVP + (size_t)((row >> 13) * 30 + (t - 8162)) * 512; }
                        else if (row < MR) { const int si = row - MP; dst = out + O_CONVS + (size_t)((si >> 2) * 30 + 26 + (si & 3)) * 512; }
                        if (dst) { *(f32x4*)(dst + pn * 128 + cl) = a0; *(f32x4*)(dst + pn * 128 + cl + 4) = a1; }
                    }
                }
        } else if (pn < 7) {
            const int g = pn - 4;
#pragma unroll
            for (int ai = 0; ai < 2; ++ai)
#pragma unroll
                for (int m = 0; m < 4; ++m) {
                    const int row = rbase + ai * HALF + m * 16; const float rs = rstd[row] * C2;
#pragma unroll
                    for (int bj = 0; bj < 2; ++bj) *(u32x4*)(Q + (size_t)row * 768 + g * 256 + bj * HALF + cl) = pack8(acc[ai][bj][m][0] * rs, acc[ai][bj][m][1] * rs);
                }
        } else if (pn < 13) {
            const bool isV = pn >= 10; const int g = isV ? pn - 10 : pn - 7, sh = 2 * g, W = 128 << sh;
            bf16_t* base = isV ? Vb : Kb;
            const size_t offp = (g == 0 ? O_KV0P : g == 1 ? O_KV1P : O_KV2P) + (isV ? 256 : 0), offs = (g == 0 ? O_KV0S : g == 1 ? O_KV1S : O_KV2S) + (isV ? 256 : 0);
            const bool hasout = smp || (tb * 256 + 256 > 8192 - W);
#pragma unroll
            for (int ai = 0; ai < 2; ++ai)
#pragma unroll
                for (int m = 0; m < 4; ++m) {
                    const int row = rbase + ai * HALF + m * 16; const float rs = rstd[row];
                    int prow = row; float* dst = nullptr;
                    if (!smp) { const int t = row & 8191; prow = (row & ~8191) + ((t & ((1 << sh) - 1)) << (13 - sh)) + (t >> sh);
                        if (hasout && t >= 8192 - W) dst = out + offp + (size_t)((row >> 13) * W + (t - (8192 - W))) * 512; }
                    else if (row < MR) { const int si = row - MP; dst = out + offs + (size_t)((si >> 2) * W + (W - 4) + (si & 3)) * 512; }
#pragma unroll
                    for (int bj = 0; bj < 2; ++bj) { const f32x4 v0 = acc[ai][bj][m][0] * rs, v1 = acc[ai][bj][m][1] * rs;
                        *(u32x4*)(base + (size_t)prow * 768 + g * 256 + bj * HALF + cl) = pack8(v0, v1);
                        if (dst) { *(f32x4*)(dst + bj * HALF + cl) = v0; *(f32x4*)(dst + bj * HALF + cl + 4) = v1; } }
                }
        } else {
            const int j = pn - 13;
#pragma unroll
            for (int ai = 0; ai < 2; ++ai)
#pragma unroll
                for (int m = 0; m < 4; ++m) {
                    const int row = rbase + ai * HALF + m * 16; const float rs = rstd[row];
                    f32x4 c0 = acc[ai][0][m][0] * rs, c1 = acc[ai][0][m][1] * rs, a0 = acc[ai][1][m][0] * rs, a1 = acc[ai][1][m][1] * rs;
#pragma unroll
                    for (int e = 0; e < 4; ++e) {
                        const float e0 = 1.0f + fminf(__builtin_amdgcn_exp2f(-1.4426950408889634f * a0[e]), 0x1p60f), e1 = 1.0f + fminf(__builtin_amdgcn_exp2f(-1.4426950408889634f * a1[e]), 0x1p60f);
                        c0[e] = sigm(c0[e]) * e0; c1[e] = sigm(c1[e]) * e1; a0[e] = __builtin_amdgcn_rcpf(e0); a1[e] = __builtin_amdgcn_rcpf(e1); }
                    *(u32x4*)(GT + (size_t)row * 2048 + 128 * j + cl) = pack8(c0, c1);
                    *(u32x4*)(GT + (size_t)row * 2048 + 1024 + 128 * j + cl) = pack8(a0, a1);
                }
        }
    }
};
__device__ __forceinline__ void rstd_rows(const float* ssq, int rbase, int fq, float (&rs)[8]) {
    const int ai_o = fq >> 1, m_o = (fq & 1) * 2, lane = (int)__builtin_amdgcn_mbcnt_hi(~0u, __builtin_amdgcn_mbcnt_lo(~0u, 0u));
    const float* p0 = ssq + (size_t)(rbase + ai_o * HALF + m_o * 16) * 16;
    f32x4 t[8];
#pragma unroll
    for (int i = 0; i < 4; ++i) { t[i] = *(const f32x4*)(p0 + 4 * i); t[4 + i] = *(const f32x4*)(p0 + 256 + 4 * i); }
    float r[2];
#pragma unroll
    for (int k = 0; k < 2; ++k) { const f32x4 a = t[4 * k], b = t[4 * k + 1], c = t[4 * k + 2], d = t[4 * k + 3];
        const float sum = (((a[0] + a[1]) + (a[2] + a[3])) + ((b[0] + b[1]) + (b[2] + b[3]))) + (((c[0] + c[1]) + (c[2] + c[3])) + ((d[0] + d[1]) + (d[2] + d[3])));
        r[k] = __builtin_amdgcn_rsqf(sum * (1.0f / 1024.0f) + cfg::EPS); }
#pragma unroll
    for (int ai = 0; ai < 2; ++ai)
#pragma unroll
        for (int m = 0; m < 4; ++m) rs[ai * 4 + m] = __shfl((m & 1) ? r[1] : r[0], (lane & 15) + 16 * (ai * 2 + (m >> 1)));
}
struct EpiGate {
    static constexpr bool PERM = true, AFTER_DRAIN = false, DRAINS = false; static constexpr int MID_T = 0;
    const bf16_t* GT; int goff; bf16_t* O;
    __device__ __forceinline__ void operator()(const f32x4 (&acc)[2][2][4][2], const Unit& u, int wr, int wc, int fr, int fq) const {
        const int rbase = u.pm * BM + wr * 64 + fr, cb = u.pn * BM + wc * 32 + 8 * fq;
        u32x4 gv[2][4][2];
        if (GT) {
#pragma unroll
            for (int ai = 0; ai < 2; ++ai)
#pragma unroll
                for (int m = 0; m < 4; ++m)
#pragma unroll
                    for (int bj = 0; bj < 2; ++bj) gv[ai][m][bj] = *(const u32x4*)(GT + (size_t)(rbase + ai * HALF + m * 16) * 2048 + goff + cb + bj * HALF);
        }
#pragma unroll
        for (int ai = 0; ai < 2; ++ai)
#pragma unroll
            for (int m = 0; m < 4; ++m) { const int row = rbase + ai * HALF + m * 16;
#pragma unroll
                for (int bj = 0; bj < 2; ++bj) { const int col = cb + bj * HALF; f32x4 v0 = acc[ai][bj][m][0], v1 = acc[ai][bj][m][1];
                    if (GT) { f32x4 g0, g1; unpack8(gv[ai][m][bj], g0, g1); v0 = v0 * g0; v1 = v1 * g1; }
                    *(u32x4*)(O + (size_t)row * 1024 + col) = pack8(v0, v1); } }
    }
};
#ifndef MIXHOOK_T
#define MIXHOOK_T 8
#endif
struct EpiMix {
    static constexpr bool PERM = true, AFTER_DRAIN = false, DRAINS = true; static constexpr int MID_T = MIXHOOK_T;
    const bf16_t* GT; bf16_t* O;
    __device__ __forceinline__ void mid(f32x4 (&acc)[2][2][4][2], const Unit& u, int wr, int wc, int fr, int fq) const {
        const int rbase = u.pm * BM + wr * 64 + fr, cb = u.pn * BM + wc * 32 + 8 * fq;
#pragma unroll
        for (int ai = 0; ai < 2; ++ai) {
            u32x4 cv[4][2];
#pragma unroll
            for (int m = 0; m < 4; ++m)
#pragma unroll
                for (int bj = 0; bj < 2; ++bj) cv[m][bj] = *(const u32x4*)(GT + (size_t)(rbase + ai * HALF + m * 16) * 2048 + cb + bj * HALF);
#pragma unroll
            for (int m = 0; m < 4; ++m)
#pragma unroll
                for (int bj = 0; bj < 2; ++bj) { f32x4 c0, c1; unpack8(cv[m][bj], c0, c1); acc[ai][bj][m][0] = acc[ai][bj][m][0] * c0; acc[ai][bj][m][1] = acc[ai][bj][m][1] * c1; }
            asm volatile("" ::: "memory");
        }
    }
    __device__ __forceinline__ void operator()(const f32x4 (&acc)[2][2][4][2], const Unit& u, int wr, int wc, int fr, int fq) const {
        const int rbase = u.pm * BM + wr * 64 + fr, cb = u.pn * BM + wc * 32 + 8 * fq;
        u32x4 gv[2][4][2];
#pragma unroll
        for (int ai = 0; ai < 2; ++ai)
#pragma unroll
            for (int m = 0; m < 4; ++m)
#pragma unroll
                for (int bj = 0; bj < 2; ++bj) gv[ai][m][bj] = *(const u32x4*)(GT + (size_t)(rbase + ai * HALF + m * 16) * 2048 + 1024 + cb + bj * HALF);
#pragma unroll
        for (int ai = 0; ai < 2; ++ai)
#pragma unroll
            for (int m = 0; m < 4; ++m) { const int row = rbase + ai * HALF + m * 16;
#pragma unroll
                for (int bj = 0; bj < 2; ++bj) { f32x4 g0, g1; unpack8(gv[ai][m][bj], g0, g1);
                    *(u32x4*)(O + (size_t)row * 1024 + cb + bj * HALF) = pack8(acc[ai][bj][m][0] * g0, acc[ai][bj][m][1] * g1); } }
    }
};
struct EpiResidIn {
    static constexpr bool PERM = true, AFTER_DRAIN = false, DRAINS = true; static constexpr int MID_T = 0;
    const float* xp; const float* xs; bf16_t* XB; float* ssq;
    __device__ __forceinline__ void operator()(const f32x4 (&acc)[2][2][4][2], const Unit& u, int wr, int wc, int fr, int fq) const {
        using namespace cfg;
        const int rbase = u.pm * BM + wr * 64 + fr, cb = u.pn * BM + wc * 32 + 8 * fq;
#pragma unroll
        for (int ai = 0; ai < 2; ++ai) {
            f32x4 xv[4][2][2];
#pragma unroll
            for (int m = 0; m < 4; ++m) { const int row = rbase + ai * HALF + m * 16; const float* src = row < MP ? xp + (size_t)row * 1024 : xs + (size_t)(row - MP) * 1024;
#pragma unroll
                for (int bj = 0; bj < 2; ++bj) { xv[m][bj][0] = (f32x4){0.f, 0.f, 0.f, 0.f}; xv[m][bj][1] = xv[m][bj][0];
                    if (row < MR) { xv[m][bj][0] = *(const f32x4*)(src + cb + bj * HALF); xv[m][bj][1] = *(const f32x4*)(src + cb + bj * HALF + 4); } } }
#pragma unroll
            for (int m = 0; m < 4; ++m) { const int row = rbase + ai * HALF + m * 16; float q = 0.f;
#pragma unroll
                for (int bj = 0; bj < 2; ++bj) { const f32x4 x0 = xv[m][bj][0] + acc[ai][bj][m][0], x1 = xv[m][bj][1] + acc[ai][bj][m][1];
                    *(u32x4*)(XB + (size_t)row * 1024 + cb + bj * HALF) = pack8(x0, x1); q += dot4(x0) + dot4(x1); }
                q += __shfl_xor(q, 16); q += __shfl_xor(q, 32);
                if (fq == 0) ssq[(size_t)row * 16 + u.pn * 4 + wc] = q; }
            asm volatile("" ::: "memory");
        }
    }
};
struct EpiResidB {
    static constexpr bool PERM = true, AFTER_DRAIN = false, DRAINS = true; static constexpr int MID_T = 0;
    bf16_t* XB; float* ssq;
    __device__ __forceinline__ void operator()(const f32x4 (&acc)[2][2][4][2], const Unit& u, int wr, int wc, int fr, int fq) const {
        const int rbase = u.pm * BM + wr * 64 + fr, cb = u.pn * BM + wc * 32 + 8 * fq;
        u32x4 xv[2][4][2];
#pragma unroll
        for (int ai = 0; ai < 2; ++ai)
#pragma unroll
            for (int m = 0; m < 4; ++m)
#pragma unroll
                for (int bj = 0; bj < 2; ++bj) xv[ai][m][bj] = *(const u32x4*)(XB + (size_t)(rbase + ai * HALF + m * 16) * 1024 + cb + bj * HALF);
#pragma unroll
        for (int ai = 0; ai < 2; ++ai)
#pragma unroll
            for (int m = 0; m < 4; ++m) { const int row = rbase + ai * HALF + m * 16; float q = 0.f;
#pragma unroll
                for (int bj = 0; bj < 2; ++bj) { f32x4 x0, x1; unpack8(xv[ai][m][bj], x0, x1); x0 = x0 + acc[ai][bj][m][0]; x1 = x1 + acc[ai][bj][m][1];
                    *(u32x4*)(XB + (size_t)row * 1024 + cb + bj * HALF) = pack8(x0, x1); q += dot4(x0) + dot4(x1); }
                q += __shfl_xor(q, 16); q += __shfl_xor(q, 32);
                if (fq == 0) ssq[(size_t)row * 16 + u.pn * 4 + wc] = q; }
    }
};
struct EpiUp {
    static constexpr bool PERM = true, AFTER_DRAIN = false, DRAINS = true; static constexpr int MID_T = 0;
    const float* ssq; bf16_t* H; const float *c0, *c1, *c2, *st; float* out;
    __device__ __forceinline__ bool cp_addr(unsigned i, const f32x4*& src, f32x4*& dst) const {
        using namespace cfg;
        constexpr unsigned P0 = 124 * 128, T0 = P0 * 32, P1 = 508 * 128, T1 = P1 * 32, P2 = 2044 * 128, T2 = P2 * 32, P3 = 26 * 128, T3 = P3 * 32;
        if (i < T0) { const unsigned bs = i / P0, r = i - bs * P0; src = (const f32x4*)(c0 + ((size_t)bs * 128 + 4) * 512) + r; dst = (f32x4*)(out + O_KV0S + (size_t)bs * 128 * 512) + r; return true; }
        i -= T0;
        if (i < T1) { const unsigned bs = i / P1, r = i - bs * P1; src = (const f32x4*)(c1 + ((size_t)bs * 512 + 4) * 512) + r; dst = (f32x4*)(out + O_KV1S + (size_t)bs * 512 * 512) + r; return true; }
        i -= T1;
        if (i < T2) { const unsigned bs = i / P2, r = i - bs * P2; src = (const f32x4*)(c2 + ((size_t)bs * 2048 + 4) * 512) + r; dst = (f32x4*)(out + O_KV2S + (size_t)bs * 2048 * 512) + r; return true; }
        i -= T2;
        if (i < T3) { const unsigned bs = i / P3, r = i - bs * P3; src = (const f32x4*)(st + ((size_t)bs * 30 + 4) * 512) + r; dst = (f32x4*)(out + O_CONVS + (size_t)bs * 30 * 512) + r; return true; }
        return false;
    }
    __device__ __forceinline__ void operator()(const f32x4 (&acc)[2][2][4][2], const Unit& u, int wr, int wc, int fr, int fq) const {
        const int rbase = u.pm * BM + wr * 64 + fr, cl = u.pn * HALF + wc * 32 + 8 * fq;
        const unsigned tid = (unsigned)((wr * 4 + wc) * 64 + fr + 16 * fq), chunk = (unsigned)(u.pm * 22 + u.pn);
        f32x4 cv[8]; f32x4* cd[8]; bool ok[8];
#pragma unroll
        for (int k = 0; k < 8; ++k) { const f32x4* sp_; ok[k] = cp_addr((chunk * 8 + k) * 512 + tid, sp_, cd[k]); if (ok[k]) cv[k] = __builtin_nontemporal_load(sp_); }
        float rsv[8]; rstd_rows(ssq, rbase, fq, rsv);
#pragma unroll
        for (int ai = 0; ai < 2; ++ai)
#pragma unroll
            for (int m = 0; m < 4; ++m) { const int row = rbase + ai * HALF + m * 16; const float rs = rsv[ai * 4 + m];
                f32x4 g0 = acc[ai][0][m][0] * rs, g1 = acc[ai][0][m][1] * rs; const f32x4 u0 = acc[ai][1][m][0] * rs, u1 = acc[ai][1][m][1] * rs;
#pragma unroll
                for (int e = 0; e < 4; ++e) { g0[e] = g0[e] * sigm(g0[e]) * u0[e]; g1[e] = g1[e] * sigm(g1[e]) * u1[e]; }
                *(u32x4*)(H + (size_t)row * cfg::DFF + cl) = pack8(g0, g1); }
#pragma unroll
        for (int k = 0; k < 8; ++k) if (ok[k]) __builtin_nontemporal_store(cv[k], cd[k]);
    }
};
struct EpiNull {
    static constexpr bool PERM = true, AFTER_DRAIN = false, DRAINS = false; static constexpr int MID_T = 0;
    __device__ __forceinline__ void operator()(const f32x4 (&acc)[2][2][4][2], const Unit& u, int wr, int wc, int fr, int fq) const {
#pragma unroll
        for (int ai = 0; ai < 2; ++ai)
#pragma unroll
            for (int bj = 0; bj < 2; ++bj)
#pragma unroll
                for (int m = 0; m < 4; ++m) { asm volatile("" :: "v"(acc[ai][bj][m][0]), "v"(acc[ai][bj][m][1])); }
    }
};
struct EpiPleNorm {
    static constexpr bool PERM = true, AFTER_DRAIN = false, DRAINS = true; static constexpr int MID_T = 0;
    const float* ssq2; const bf16_t* PP; const bf16_t* XB; float* out; float* ssq3; unsigned* pcnt; const float* gfin; unsigned* tmo; PG8_LAS float* part;
    __device__ __forceinline__ void operator()(const f32x4 (&acc_)[2][2][4][2], const Unit& u, int wr, int wc, int fr, int fq) const {
        using namespace cfg;
        f32x4 (&acc)[2][2][4][2] = const_cast<f32x4 (&)[2][2][4][2]>(acc_);
        const int rbase = u.pm * BM + wr * 64 + fr, cb = u.pn * BM + wc * 32 + 8 * fq, lane = fr + 16 * fq, tid = (wr * 4 + wc) * 64 + lane;
        float rsv[8]; rstd_rows(ssq2, rbase, fq, rsv);
#pragma unroll
        for (int ai = 0; ai < 2; ++ai) {
            u32x4 pv[4][2], xv[4][2];
#pragma unroll
            for (int m = 0; m < 4; ++m)
#pragma unroll
                for (int bj = 0; bj < 2; ++bj) { const size_t ro = (size_t)(rbase + ai * HALF + m * 16) * 1024 + cb + bj * HALF; pv[m][bj] = *(const u32x4*)(PP + ro); xv[m][bj] = *(const u32x4*)(XB + ro); }
#pragma unroll
            for (int m = 0; m < 4; ++m) { const int rl = wr * 64 + fr + ai * HALF + m * 16; const float rs = rsv[ai * 4 + m]; float q = 0.f;
#pragma unroll
                for (int bj = 0; bj < 2; ++bj) { f32x4 x0, x1, p0, p1; unpack8(pv[m][bj], p0, p1); unpack8(xv[m][bj], x0, x1);
                    const f32x4 s0 = acc[ai][bj][m][0] * rs, s1 = acc[ai][bj][m][1] * rs;
#pragma unroll
                    for (int e = 0; e < 4; ++e) { x0[e] += sigm(s0[e]) * p0[e]; x1[e] += sigm(s1[e]) * p1[e]; }
                    acc[ai][bj][m][0] = x0; acc[ai][bj][m][1] = x1; q += dot4(x0) + dot4(x1); }
                q += __shfl_xor(q, 16); q += __shfl_xor(q, 32);
                if (fq == 0) part[rl * 4 + wc] = q; }
            asm volatile("" ::: "memory");
        }
        asm volatile("s_waitcnt lgkmcnt(0)" ::: "memory"); __builtin_amdgcn_s_barrier(); asm volatile("" ::: "memory");
        if (tid < 256) { const f32x4 p4 = *(const PG8_LAS f32x4*)(part + tid * 4);
            __hip_atomic_store(ssq3 + (size_t)(u.pm * BM + tid) * 4 + u.pn, (p4[0] + p4[1]) + (p4[2] + p4[3]), __ATOMIC_RELAXED, __HIP_MEMORY_SCOPE_AGENT); }
        asm volatile("s_waitcnt vmcnt(0)" ::: "memory"); __builtin_amdgcn_s_barrier(); asm volatile("" ::: "memory");
        unsigned* cw = pcnt + 64 * u.pm;
        if (tid == 0) __hip_atomic_fetch_add(cw, 1u, __ATOMIC_RELAXED, __HIP_MEMORY_SCOPE_AGENT);
        { unsigned sp = 0;
            while ((unsigned)__builtin_amdgcn_readfirstlane(__hip_atomic_load(cw, __ATOMIC_RELAXED, __HIP_MEMORY_SCOPE_AGENT)) < 4u) {
                __builtin_amdgcn_s_sleep(2);
                if (++sp > (1u << 20)) { if (lane == 0) __hip_atomic_store(tmo, 1u, __ATOMIC_RELAXED, __HIP_MEMORY_SCOPE_AGENT); break; } }
            __builtin_amdgcn_fence(__ATOMIC_ACQUIRE, "agent"); }
        float r3[8];
        { const int ai_o = fq >> 1, m_o = (fq & 1) * 2; const float* p0 = ssq3 + (size_t)(rbase + ai_o * HALF + m_o * 16) * 4;
          const f32x4 a = *(const f32x4*)p0, b = *(const f32x4*)(p0 + 64);
          const float ra = __builtin_amdgcn_rsqf(((a[0] + a[1]) + (a[2] + a[3])) * (1.0f / 1024.0f) + EPS), rb = __builtin_amdgcn_rsqf(((b[0] + b[1]) + (b[2] + b[3])) * (1.0f / 1024.0f) + EPS);
#pragma unroll
          for (int ai = 0; ai < 2; ++ai)
#pragma unroll
              for (int m = 0; m < 4; ++m) r3[ai * 4 + m] = __shfl((m & 1) ? rb : ra, fr + 16 * (ai * 2 + (m >> 1))); }
        f32x4 gv[2][2];
#pragma unroll
        for (int bj = 0; bj < 2; ++bj) { gv[bj][0] = *(const f32x4*)(gfin + cb + bj * HALF); gv[bj][1] = *(const f32x4*)(gfin + cb + bj * HALF + 4); }
#pragma unroll
        for (int ai = 0; ai < 2; ++ai)
#pragma unroll
            for (int m = 0; m < 4; ++m) { const int row = rbase + ai * HALF + m * 16; const float rs = r3[ai * 4 + m]; float* dst = out + (size_t)row * 1024;
                if (row < MR) {
#pragma unroll
                    for (int bj = 0; bj < 2; ++bj) { *(f32x4*)(dst + cb + bj * HALF) = acc[ai][bj][m][0] * rs * gv[bj][0]; *(f32x4*)(dst + cb + bj * HALF + 4) = acc[ai][bj][m][1] * rs * gv[bj][1]; } } }
    }
};

template <class Epi, class Sched, bool ALIGN_EPI = false, bool SP2 = false>
__device__ __forceinline__ void gemm_phase(PG8_LAS unsigned char* lds, const Gemm g, const Sched& S, const Epi& E, const int wave_id  ) {
    unsigned z_ = 0u; asm volatile("" : "+s"(z_)); int tid_ = wave_id * 64 + (int)__builtin_amdgcn_mbcnt_hi(~0u, __builtin_amdgcn_mbcnt_lo(~0u, z_)); asm volatile("" : "+v"(tid_));
    const int tid = tid_, wid = __builtin_amdgcn_readfirstlane(tid >> 6), lane = tid & 63, wr = wid >> 2, wc = wid & 3, fr = lane & 15, fq = lane >> 4;
    const int K = g.K, nt = K / BK, LD = g.ld;
    unsigned voffA[2], voffB[2];
#pragma unroll
    for (int i = 0; i < 2; ++i) { int R, C; stage_rc(tid * 16 + i * 8192, R, C); const int Rb = Epi::PERM ? ((R & ~31) + perm32(R & 31)) : R;
        voffA[i] = (unsigned)(R * LD + C) * 2u; voffB[i] = (unsigned)(Rb * LD + C) * 2u; }
    const size_t kstep = (size_t)(BK * 2);
    const size_t hstep = (size_t)HALF * LD * 2;
    const size_t tstep = 2 * hstep;
    const unsigned ldsw = (unsigned)wid * 1024u;
    const int aoff = lds_byte(wr * 64 + fr, fq * 8), boff = lds_byte(wc * 32 + fr, fq * 8);
#define PG8_SA(b, h) (((b) * 2 + (h)) * HTB)
#define PG8_SB(b, h) ((4 + (b) * 2 + (h)) * HTB)
#define PG8_STAGE(bufoff, gbase, voff) do { _Pragma("unroll") for (int _i = 0; _i < 2; ++_i) \
        __builtin_amdgcn_global_load_lds((const unsigned*)((const char*)(gbase) + (voff)[_i]), (PG8_LAS unsigned*)(lds + (bufoff) + ldsw + _i * 8192), 16, 0, 0); } while (0)
#define PG8_LDA(dst, b, h) do { _Pragma("unroll") for (int m = 0; m < 4; ++m) _Pragma("unroll") for (int k = 0; k < 2; ++k) dst[m][k] = *(const PG8_LAS bf16x8*)(lds + PG8_SA(b, h) + aoff + m * 2048 + k * 1024); } while (0)
#define PG8_LDB(dst, b, h) do { _Pragma("unroll") for (int n = 0; n < 2; ++n) _Pragma("unroll") for (int k = 0; k < 2; ++k) dst[n][k] = *(const PG8_LAS bf16x8*)(lds + PG8_SB(b, h) + boff + n * 2048 + k * 1024); } while (0)
#define PG8_MMA(ai, bj, At, Bt) do { __builtin_amdgcn_s_setprio(1); _Pragma("unroll") for (int m = 0; m < 4; ++m) _Pragma("unroll") for (int n = 0; n < 2; ++n) _Pragma("unroll") for (int k = 0; k < 2; ++k) \
        acc[ai][bj][m][n] = __builtin_amdgcn_mfma_f32_16x16x32_bf16(Bt[n][k], At[m][k], acc[ai][bj][m][n], 0, 0, 0); __builtin_amdgcn_s_setprio(0); } while (0)
#define PG8_WAIT_V(n) asm volatile("s_waitcnt vmcnt(" #n ")" ::: "memory")
#define PG8_WAIT_L(n) asm volatile("s_waitcnt lgkmcnt(" #n ")" ::: "memory")
#define PG8_BAR __builtin_amdgcn_s_barrier()
#define PG8_SCHED __builtin_amdgcn_sched_barrier(0)
    Unit cur, nxt; int ui = 0;
    if (!S.next(0, cur)) return;
    f32x4 acc[2][2][4][2];
#pragma unroll
    for (int a = 0; a < 2; ++a)
#pragma unroll
        for (int b = 0; b < 2; ++b)
#pragma unroll
            for (int m = 0; m < 4; ++m)
#pragma unroll
                for (int n = 0; n < 2; ++n) acc[a][b][m][n] = (f32x4){0.f, 0.f, 0.f, 0.f};
    bf16x8 At[4][2], B0[2][2], B1[2][2];
    const char* cA = (const char*)g.A + (size_t)cur.pm * tstep; const char* cB = (const char*)g.Bt + (size_t)cur.pn * tstep;
    S.a_ready(cur);
    if constexpr (SP2) {
        PG8_STAGE(PG8_SB(0, 0), cB, voffB); PG8_STAGE(PG8_SB(0, 1), cB + hstep, voffB); PG8_STAGE(PG8_SA(0, 0), cA, voffA); PG8_STAGE(PG8_SA(0, 1), cA + hstep, voffA);
        if (wr == 1) PG8_BAR;
        PG8_WAIT_V(2); PG8_BAR;
        PG8_STAGE(PG8_SB(1, 0), cB + kstep, voffB); PG8_STAGE(PG8_SA(1, 0), cA + kstep, voffA); PG8_STAGE(PG8_SB(1, 1), cB + hstep + kstep, voffB);
        PG8_WAIT_V(6); PG8_BAR;
    } else {
        PG8_STAGE(PG8_SB(0, 0), cB, voffB); PG8_STAGE(PG8_SA(0, 0), cA, voffA); PG8_STAGE(PG8_SB(0, 1), cB + hstep, voffB); PG8_STAGE(PG8_SA(0, 1), cA + hstep, voffA);
        if (wr == 1) PG8_BAR;
        PG8_WAIT_V(4); PG8_BAR;
        PG8_STAGE(PG8_SB(1, 0), cB + kstep, voffB); PG8_STAGE(PG8_SA(1, 0), cA + kstep, voffA); PG8_STAGE(PG8_SB(1, 1), cB + hstep + kstep, voffB);
        PG8_WAIT_V(6); PG8_BAR;
    }
    for (;;) {
        const bool has_next = S.next(ui + 1, nxt);
        const char* nA = has_next ? (const char*)g.A + (size_t)nxt.pm * tstep : cA; const char* nB = has_next ? (const char*)g.Bt + (size_t)nxt.pn * tstep : cB;
        for (int t = 0; t < nt; t += 2) {
            if constexpr (Epi::MID_T > 0) { if (t == Epi::MID_T) {
                unsigned z3_ = 0u; asm volatile("" : "+s"(z3_)); int l3_ = (int)__builtin_amdgcn_mbcnt_hi(~0u, __builtin_amdgcn_mbcnt_lo(~0u, z3_)); asm volatile("" : "+v"(l3_));
                E.mid(acc, cur, wr, wc, l3_ & 15, l3_ >> 4); } }
            const bool last = (t == nt - 2);
            const char* a1 = cA + (size_t)(t + 1) * kstep;
            const char* a2 = last ? nA : cA + (size_t)(t + 2) * kstep; const char* b2 = last ? nB : cB + (size_t)(t + 2) * kstep;
            const char* a3 = a2 + kstep; const char* b3 = b2 + kstep;
            if (last && has_next) S.a_ready(nxt);
            if constexpr (SP2) {
            PG8_LDB(B0, 0, 0); PG8_LDB(B1, 0, 1); PG8_SCHED; PG8_LDA(At, 0, 0); PG8_STAGE(PG8_SA(1, 1), a1 + hstep, voffA);
            PG8_WAIT_V(8); PG8_WAIT_L(0); PG8_BAR; PG8_MMA(0, 0, At, B0); PG8_MMA(0, 1, At, B1); PG8_BAR; PG8_SCHED;
            PG8_LDA(At, 0, 1); PG8_STAGE(PG8_SB(0, 0), b2, voffB); PG8_STAGE(PG8_SB(0, 1), b2 + hstep, voffB); PG8_STAGE(PG8_SA(0, 0), a2, voffA);
            PG8_WAIT_V(8); PG8_WAIT_L(0); PG8_BAR; PG8_MMA(1, 0, At, B0); PG8_MMA(1, 1, At, B1); PG8_BAR; PG8_SCHED;
            PG8_LDB(B0, 1, 0); PG8_LDB(B1, 1, 1); PG8_SCHED; PG8_LDA(At, 1, 0); PG8_STAGE(PG8_SA(0, 1), a2 + hstep, voffA);
            PG8_WAIT_V(8); PG8_WAIT_L(0); PG8_BAR; PG8_MMA(0, 0, At, B0); PG8_MMA(0, 1, At, B1); PG8_BAR; PG8_SCHED;
            PG8_LDA(At, 1, 1); PG8_STAGE(PG8_SB(1, 0), b3, voffB); PG8_STAGE(PG8_SB(1, 1), b3 + hstep, voffB); PG8_STAGE(PG8_SA(1, 0), a3, voffA);
            PG8_WAIT_V(8); PG8_WAIT_L(0); PG8_BAR; PG8_MMA(1, 0, At, B0); PG8_MMA(1, 1, At, B1); PG8_BAR; PG8_SCHED;
            } else {
            PG8_LDB(B0, 0, 0); PG8_SCHED; PG8_LDA(At, 0, 0); PG8_STAGE(PG8_SA(1, 1), a1 + hstep, voffA);
            PG8_WAIT_L(8); PG8_BAR; PG8_WAIT_L(0); PG8_MMA(0, 0, At, B0); PG8_BAR; PG8_SCHED;
            PG8_LDB(B1, 0, 1); PG8_STAGE(PG8_SB(0, 0), b2, voffB);
            PG8_BAR; PG8_WAIT_L(0); PG8_MMA(0, 1, At, B1); PG8_BAR;
            PG8_LDA(At, 0, 1); PG8_STAGE(PG8_SA(0, 0), a2, voffA);
            PG8_BAR; PG8_WAIT_L(0); PG8_MMA(1, 0, At, B0); PG8_BAR; PG8_SCHED;
            PG8_STAGE(PG8_SB(0, 1), b2 + hstep, voffB);
            PG8_WAIT_V(6); PG8_BAR; PG8_MMA(1, 1, At, B1); PG8_BAR;
            PG8_LDB(B0, 1, 0); PG8_SCHED; PG8_LDA(At, 1, 0); PG8_STAGE(PG8_SA(0, 1), a2 + hstep, voffA);
            PG8_WAIT_L(8); PG8_BAR; PG8_WAIT_L(0); PG8_MMA(0, 0, At, B0); PG8_BAR; PG8_SCHED;
            PG8_LDB(B1, 1, 1); PG8_STAGE(PG8_SB(1, 0), b3, voffB);
            PG8_BAR; PG8_WAIT_L(0); PG8_MMA(0, 1, At, B1); PG8_BAR;
            PG8_LDA(At, 1, 1); PG8_STAGE(PG8_SA(1, 0), a3, voffA);
            PG8_BAR; PG8_WAIT_L(0); PG8_MMA(1, 0, At, B0); PG8_BAR; PG8_SCHED;
            PG8_STAGE(PG8_SB(1, 1), b3 + hstep, voffB);
            PG8_WAIT_V(6); PG8_BAR; PG8_MMA(1, 1, At, B1); PG8_BAR;
            }
        }
        if constexpr (ALIGN_EPI) { if (wr == 0) PG8_BAR; }
        if constexpr (!Epi::AFTER_DRAIN) {
            unsigned z2_ = 0u; asm volatile("" : "+s"(z2_)); int l2_ = (int)__builtin_amdgcn_mbcnt_hi(~0u, __builtin_amdgcn_mbcnt_lo(~0u, z2_)); asm volatile("" : "+v"(l2_));
            E(acc, cur, wr, wc, l2_ & 15, l2_ >> 4); S.done(cur); }
        if (!has_next) break;
#pragma unroll
        for (int a = 0; a < 2; ++a)
#pragma unroll
            for (int b = 0; b < 2; ++b)
#pragma unroll
                for (int m = 0; m < 4; ++m)
#pragma unroll
                    for (int n = 0; n < 2; ++n) acc[a][b][m][n] = (f32x4){0.f, 0.f, 0.f, 0.f};
        cur = nxt; cA = nA; cB = nB; ++ui;
        if constexpr (ALIGN_EPI) { if (wr == 1) PG8_BAR; }
    }
    PG8_WAIT_V(0);
    if constexpr (!ALIGN_EPI) { if (wr == 0) PG8_BAR; }
    PG8_BAR;
    if constexpr (Epi::AFTER_DRAIN) { E.fused(acc, cur, wr, wc, fr, fq, lds, wid, lane); S.done(cur); }
#undef PG8_SA
#undef PG8_SB
#undef PG8_STAGE
#undef PG8_LDA
#undef PG8_LDB
#undef PG8_MMA
#undef PG8_WAIT_V
#undef PG8_WAIT_L
#undef PG8_BAR
#undef PG8_SCHED
}
}
#define GAS __attribute__((address_space(1)))
#define LAS __attribute__((address_space(3)))
typedef unsigned short bf16;
typedef unsigned v4u __attribute__((ext_vector_type(4)));
typedef float f32x4 __attribute__((ext_vector_type(4)));
typedef short bf16x8 __attribute__((ext_vector_type(8)));
typedef GAS unsigned gu32;
typedef GAS unsigned long long gu64;
#define RLX_AGENT __ATOMIC_RELAXED, __HIP_MEMORY_SCOPE_AGENT
#define LDS_WAIT() asm volatile("s_waitcnt lgkmcnt(0)" ::: "memory")
#define VM_WAIT() asm volatile("s_waitcnt vmcnt(0)" ::: "memory")
__device__ __forceinline__ unsigned long long rt() { return __builtin_amdgcn_s_memrealtime(); }
__device__ __forceinline__ unsigned f2bf(float f) { unsigned u = __builtin_bit_cast(unsigned, f); return (u + 0x7fffu + ((u >> 16) & 1u)) >> 16; }
__device__ __forceinline__ unsigned pk2(float lo, float hi) { return f2bf(lo) | (f2bf(hi) << 16); }
#define XB_TMO      128
#define XB_XCNT(j)  (256  + 64 * (j))
#define XB_XSUB(j)  (1280 + 64 * (j))
#define XB_XGEN(j)  (2304 + 64 * (j))
#define XB_TOP      3328
#define XB_TOPGEN   3392
#define XCD_BAR_WORDS 3456
#define XB_SPIN_CAP (1u << 18)

__device__ __forceinline__ unsigned xb_ld(unsigned* p)              { return __hip_atomic_load(p, __ATOMIC_RELAXED, __HIP_MEMORY_SCOPE_AGENT); }
__device__ __forceinline__ unsigned xb_add(unsigned* p, unsigned v) { return __hip_atomic_fetch_add(p, v, __ATOMIC_RELAXED, __HIP_MEMORY_SCOPE_AGENT); }
__device__ __forceinline__ unsigned xb_xcc_id() { return (unsigned)__builtin_amdgcn_s_getreg((3 << 11) | 20) & 0xFu; }
#define XB_SPIN(cond, bar) do { unsigned _sp = 0; while (cond) { __builtin_amdgcn_s_sleep(1); \
    if ((++_sp & 255u) == 0u) { if (xb_ld(&(bar)[XB_TMO])) break; if (_sp > XB_SPIN_CAP) { atomicAdd(&(bar)[XB_TMO], 1u); break; } } } } while (0)

struct XcdBarrier {
    unsigned* bar; unsigned x; unsigned gsize;
    volatile LAS unsigned* st;
};

__device__ __forceinline__ XcdBarrier xcd_barrier_post(unsigned* bar, volatile LAS unsigned* st) {
    XcdBarrier b; b.bar = bar; b.x = xb_xcc_id(); b.st = st; b.gsize = 0u;
    if (threadIdx.x == 0) (void)xb_add(&bar[XB_XCNT(b.x)], 1u);
    return b;
}
__device__ __forceinline__ void xcd_barrier_complete(unsigned* bar, unsigned x, unsigned& nloc, unsigned& nx, unsigned gsize = 0u) {
    const unsigned G = gsize ? gsize : gridDim.x * gridDim.y * gridDim.z;
    unsigned sum, cnt, mine, sp = 0u;
    for (;;) {
        sum = 0u; cnt = 0u; mine = 0u;
#pragma unroll
        for (unsigned j = 0; j < 16; ++j) { const unsigned c = xb_ld(&bar[XB_XCNT(j)]); sum += c; cnt += (c > 0u) ? 1u : 0u; mine = (j == x) ? c : mine; }
        if (sum == G) break;
        __builtin_amdgcn_s_sleep(1);
        if ((++sp & 255u) == 0u) { if (xb_ld(&bar[XB_TMO])) break; if (sp > XB_SPIN_CAP) { atomicAdd(&bar[XB_TMO], 1u); break; } }
    }
    nloc = mine > 0u ? mine : 1u; nx = cnt > 0u ? cnt : 1u;
}

__device__ __forceinline__ void xcd_barrier(const XcdBarrier& b) {
    asm volatile("s_waitcnt vmcnt(0)" ::: "memory");
    __syncthreads();
    if (threadIdx.x == 0) {
        unsigned* bar = b.bar;
        __builtin_amdgcn_s_waitcnt(0);
        unsigned nloc = b.st[0], nx = b.st[1];
        if (nloc == 0u) { xcd_barrier_complete(bar, b.x, nloc, nx, b.gsize); b.st[0] = nloc; b.st[1] = nx; }
        const unsigned old = xb_add(&bar[XB_XSUB(b.x)], 1u);
        const unsigned gen = old / nloc;
        if (old + 1u == (gen + 1u) * nloc) {
            __builtin_amdgcn_fence(__ATOMIC_RELEASE, "agent");
            asm volatile("s_waitcnt vmcnt(0)" ::: "memory");
            const unsigned og = xb_add(&bar[XB_TOP], 1u);
            const unsigned tg = og / nx;
            if (og + 1u == (tg + 1u) * nx) xb_add(&bar[XB_TOPGEN], 1u);
            else XB_SPIN(xb_ld(&bar[XB_TOPGEN]) == tg, bar);
            __builtin_amdgcn_fence(__ATOMIC_ACQUIRE, "agent");
            xb_add(&bar[XB_XGEN(b.x)], 1u);
            asm volatile("s_waitcnt vmcnt(0)" ::: "memory");
        } else {
            XB_SPIN(xb_ld(&bar[XB_XGEN(b.x)]) == gen, bar);
            __builtin_amdgcn_fence(__ATOMIC_ACQUIRE, "agent");
            asm volatile("s_waitcnt vmcnt(0)" ::: "memory");
        }
    }
    __syncthreads();
}


using namespace cfg;
constexpr int NWAVES = 8, NTHREADS = 512;
#ifndef MK_N_LAUNCHES
#define MK_N_LAUNCHES 1
#endif
constexpr int NPHASE = 9;
constexpr int N_LAUNCHES = MK_N_LAUNCHES;

constexpr size_t MiB = 1u << 20;
constexpr size_t WS_CTL = 0, CTL_ZERO_BYTES = 400 * 1024;
constexpr size_t WS_RSTD0 = 1 * MiB, WS_SSQ1 = 2 * MiB, WS_SSQ2 = 5 * MiB, WS_SSQ3 = 8 * MiB;
constexpr size_t WS_W_IN = 12 * MiB, WS_W_C = 23 * MiB, WS_W_A = 24 * MiB, WS_W_O = 25 * MiB, WS_W_UP = 27 * MiB, WS_W_DN = 38 * MiB, WS_W_PG = 44 * MiB, WS_W_PL = 46 * MiB;
constexpr size_t WS_PB = 48 * MiB;
constexpr size_t WS_XB = 66 * MiB;
constexpr size_t WS_CO = WS_XB;
constexpr size_t WS_R1 = 132 * MiB;
constexpr size_t WS_U = WS_R1, WS_Q = WS_R1 + 33 * MiB, WS_K = WS_R1 + 82 * MiB, WS_V = WS_R1 + 131 * MiB;
constexpr size_t WS_MIX = WS_R1, WS_H = WS_R1;
constexpr size_t WS_GT = 312 * MiB;
constexpr size_t WS_PP = 441 * MiB;
constexpr size_t WS_SMP = 506 * MiB;
constexpr size_t WS_SMP_CO = WS_SMP, WS_SMP_MIX = WS_SMP + 512 * 1024, WS_SMP_H = WS_SMP + 2 * MiB;
constexpr size_t WS_END = 510 * MiB;
static_assert(WS_PP + (size_t)MPAD * 1024 * 2 <= WS_SMP && WS_END <= 512 * MiB, "ws map 0");
static_assert(WS_V + (size_t)MPAD * 768 * 2 <= WS_GT && WS_H + (size_t)MPAD * DFF * 2 <= WS_GT && WS_GT + (size_t)MPAD * 2048 * 2 <= WS_END, "ws map");
static_assert(WS_CO + (size_t)MPAD * 768 * 2 <= WS_R1 && WS_PB + (size_t)MPAD * 256 * 2 <= WS_XB, "ws map 2");
static_assert(WS_W_IN + (size_t)NIN * 1024 * 2 <= WS_W_C && WS_W_UP + (size_t)2 * DFF * 1024 * 2 <= WS_W_DN && WS_W_DN + (size_t)DFF * 1024 * 2 <= WS_W_PG && WS_SSQ1 + (size_t)MPAD * 64 <= WS_SSQ2, "ws map 3");
constexpr int CW_BAR = 1024, CW_PBAR = 31744, CW_SBAR = 35200, CW_PFLAG = 38784, CW_GBAR = 40960;

constexpr int RING_BYTES = 131072, LDSCTL_OFF = RING_BYTES, MISC_OFF = LDSCTL_OFF + 320, LDS_BYTES = 147456;

struct Args { const float* in[25]; float* out; unsigned char* ws; int ph_lo, ph_hi; };

#define DPPF(v, ctrl) __builtin_bit_cast(float, __builtin_amdgcn_update_dpp(0, __builtin_bit_cast(int, (v)), (ctrl), 0xf, 0xf, false))
#define RDLF(v, l) __builtin_bit_cast(float, __builtin_amdgcn_readlane(__builtin_bit_cast(int, (v)), (l)))
__device__ __forceinline__ float wave_sum(float v) {
    v += DPPF(v, 0xB1); v += DPPF(v, 0x4E); v += DPPF(v, 0x141); v += DPPF(v, 0x140);
    return (RDLF(v, 0) + RDLF(v, 16)) + (RDLF(v, 32) + RDLF(v, 48));
}
__device__ __forceinline__ float wave_max(float v) {
    v = fmaxf(v, DPPF(v, 0xB1)); v = fmaxf(v, DPPF(v, 0x4E)); v = fmaxf(v, DPPF(v, 0x141)); v = fmaxf(v, DPPF(v, 0x140));
    return fmaxf(fmaxf(RDLF(v, 0), RDLF(v, 16)), fmaxf(RDLF(v, 32), RDLF(v, 48)));
}
__device__ __forceinline__ float bflo(unsigned w) { return __uint_as_float(w << 16); }
__device__ __forceinline__ float bfhi(unsigned w) { return __uint_as_float(w & 0xffff0000u); }
__device__ __forceinline__ float fsig(float x) { return __builtin_amdgcn_rcpf(1.0f + __builtin_amdgcn_exp2f(-1.4426950408889634f * x)); }

__device__ __forceinline__ void p0_transpose_item(const float* W, int ldw, int k0, int n0, bf16* WT, int ldt, int row0, const float* gk, LAS float* scr, int lane, int kd0 = 0) {
    { f32x4 t4[8];
#pragma unroll
        for (int i = 0; i < 8; ++i) { const int kk = 8 * i + (lane >> 3); t4[i] = *(const f32x4*)(W + (size_t)(k0 + kk) * ldw + n0 + 4 * (lane & 7)); }
#pragma unroll
        for (int i = 0; i < 8; ++i) { const int kk = 8 * i + (lane >> 3); const float gs = gk ? gk[k0 + kk] : 1.0f; LAS float* d = scr + kk * 33 + 4 * (lane & 7);
            d[0] = t4[i][0] * gs; d[1] = t4[i][1] * gs; d[2] = t4[i][2] * gs; d[3] = t4[i][3] * gs; } }
    LDS_WAIT(); asm volatile("" ::: "memory");
    const int c = lane & 7;
#pragma unroll
    for (int j = 0; j < 4; ++j) { const int n = (lane >> 3) + 8 * j; const LAS float* s = scr + (8 * c) * 33 + n;
        v4u o; o.x = pk2(s[0 * 33], s[1 * 33]); o.y = pk2(s[2 * 33], s[3 * 33]); o.z = pk2(s[4 * 33], s[5 * 33]); o.w = pk2(s[6 * 33], s[7 * 33]);
        *(GAS v4u*)(WT + (size_t)(row0 + n) * ldt + kd0 + k0 + 8 * c) = o; }
    LDS_WAIT(); asm volatile("" ::: "memory");
}
__device__ __forceinline__ void p0_mat_item(const float* W, int K, int ldw, int csrc0, int ncols, bf16* WT, int ldt, int row0, const float* gk, LAS float* scr, int it, int lane, int kd0 = 0) {
    const int nblk = ncols / 32, kb = it / nblk, nb = it % nblk;
    p0_transpose_item(W, ldw, 64 * kb, csrc0 + 32 * nb, WT, ldt, row0 + 32 * nb, gk, scr, lane, kd0);
}

typedef float f32x16 __attribute__((ext_vector_type(16)));
typedef short v4i16_t __attribute__((ext_vector_type(4)));
__device__ __forceinline__ int crow(int r, int hi) { return (r & 3) + 8 * (r >> 2) + 4 * hi; }
constexpr int VPITCH = 144;
constexpr int ATT_WSF = 32 * VPITCH, ATT_OST = ATT_WSF + 256, ATT_WAVE_BYTES = 9216;
static_assert(ATT_OST + 4096 <= ATT_WAVE_BYTES && ATT_WAVE_BYTES * NWAVES <= RING_BYTES, "attention LDS");

struct AttState { float m, l; f32x16 o0, o1; };

__device__ __forceinline__ void att_tile(const bool MASKED  , AttState& st, const bf16x8 (&kf)[4], const v4u (&vv)[4], const bf16x8 (&qf)[4], int n, int uq, float slope2,
                                         LAS unsigned char* wl, const LAS unsigned char* vtr0, int lane) {
    const int c = lane & 31, h = lane >> 5;
    LAS float* wsf = (LAS float*)(wl + ATT_WSF);
    f32x16 s = {};
#pragma unroll
    for (int k = 0; k < 4; ++k) s = __builtin_amdgcn_mfma_f32_32x32x16_bf16(kf[k], qf[k], s, 0, 0, 0);
#pragma unroll
    for (int i = 0; i < 4; ++i) *(LAS v4u*)(wl + (lane >> 1) * VPITCH + (lane & 1) * 64 + 16 * i) = vv[i];
    asm volatile("" ::: "memory");
    const int dbase = uq - 32 * n - 4 * h;
    const float tc = -slope2 * (float)dbase;
    float mx = -INFINITY;
    if (MASKED) {
#pragma unroll
        for (int r = 0; r < 16; ++r) { const int ko = (r & 3) + 8 * (r >> 2); s[r] = ((unsigned)(dbase - ko) <= 128u) ? s[r] : -INFINITY; }
    }
#pragma unroll
    for (int r = 0; r < 16; ++r) { const int ko = (r & 3) + 8 * (r >> 2); s[r] += slope2 * (float)ko; mx = fmaxf(mx, s[r]); }
    mx += tc; { const auto sw = __builtin_amdgcn_permlane32_swap(__float_as_uint(mx), __float_as_uint(mx), false, false); mx = fmaxf(__uint_as_float(sw[0]), __uint_as_float(sw[1])); }
    if (__any(mx > st.m + 8.0f)) {
        const float mnew = fmaxf(st.m, mx), f = __builtin_amdgcn_exp2f(st.m - mnew);
        st.l *= f; st.m = mnew;
        if (h == 0) wsf[c] = f;
        asm volatile("" ::: "memory");
#pragma unroll
        for (int r = 0; r < 16; ++r) { const float fr_ = wsf[crow(r, h)]; st.o0[r] *= fr_; st.o1[r] *= fr_; }
        asm volatile("" ::: "memory");
    }
    const float off = tc - st.m; float ps = 0.f;
#pragma unroll
    for (int r = 0; r < 16; ++r) { s[r] = __builtin_amdgcn_exp2f(s[r] + off); ps += s[r]; }
    st.l += ps;
    v4u pw0, pw1;
    pw0.x = pg8::cvt_pk_bf16(s[0], s[1]); pw0.y = pg8::cvt_pk_bf16(s[2], s[3]); pw0.z = pg8::cvt_pk_bf16(s[4], s[5]); pw0.w = pg8::cvt_pk_bf16(s[6], s[7]);
    pw1.x = pg8::cvt_pk_bf16(s[8], s[9]); pw1.y = pg8::cvt_pk_bf16(s[10], s[11]); pw1.z = pg8::cvt_pk_bf16(s[12], s[13]); pw1.w = pg8::cvt_pk_bf16(s[14], s[15]);
    const bf16x8 pa0 = __builtin_bit_cast(bf16x8, pw0), pa1 = __builtin_bit_cast(bf16x8, pw1);
#pragma unroll
    for (int nb = 0; nb < 2; ++nb)
#pragma unroll
        for (int ks = 0; ks < 2; ++ks) {
            const LAS unsigned char* p = vtr0 + (16 * ks) * VPITCH + 64 * nb;
            const v4i16_t lo = __builtin_amdgcn_ds_read_tr16_b64_v4i16((LAS v4i16_t*)p);
            const v4i16_t hi = __builtin_amdgcn_ds_read_tr16_b64_v4i16((LAS v4i16_t*)(p + 8 * VPITCH));
            const bf16x8 vf = (bf16x8){lo[0], lo[1], lo[2], lo[3], hi[0], hi[1], hi[2], hi[3]};
            if (nb == 0) st.o0 = __builtin_amdgcn_mfma_f32_32x32x16_bf16(ks == 0 ? pa0 : pa1, vf, st.o0, 0, 0, 0);
            else         st.o1 = __builtin_amdgcn_mfma_f32_32x32x16_bf16(ks == 0 ? pa0 : pa1, vf, st.o1, 0, 0, 0);
        }
    asm volatile("" ::: "memory");
}
constexpr int ATT2_WAVE_BYTES = 4864, ATT2_COMB = 40960, ATT2_LSE = ATT2_COMB + 65536;
static_assert(ATT2_WAVE_BYTES >= ATT_WSF + 256 && ATT2_WAVE_BYTES * NWAVES <= ATT2_COMB && ATT2_LSE + 2048 <= RING_BYTES, "attention LDS (regrouped)");
template <int G, bool FIRST>
__device__ __forceinline__ void att_job2(const bf16* Q, const bf16* Kb, const bf16* Vb, int b, int slot, int sp, int jq, LAS unsigned char* wl, LAS bf16* comb, LAS float* lsea, int lane) {
    constexpr int SH = 2 * G, D = 1 << SH, SG = 8192 >> SH;
    const int c = lane & 31, h = lane >> 5;
    int tl0, ts, rg, u0;
    if (G == 2) { tl0 = jq; ts = 16; rg = jq; u0 = 32 * sp; }
    else if (G == 1) { tl0 = 128 * (jq >> 2) + (jq & 3); ts = 4; rg = jq & 3; u0 = 128 * sp + 32 * (jq >> 2); }
    else { tl0 = 32 * jq; ts = 1; rg = 0; u0 = 512 * sp + 32 * jq; }
    float slope2 = __builtin_amdgcn_exp2f(-8.0f * (float)(4 * G + slot + 1) / 12.0f) * (1.4426950408889634f * (float)D);
    asm volatile("" : "+v"(slope2));
    const int colb = 256 * G + 64 * slot, uq = u0 + c;
    const bf16* qp = Q + ((size_t)b * 8192 + 512 * sp + tl0 + ts * c) * 768 + colb + 8 * h;
    bf16x8 qf[4];
#pragma unroll
    for (int s = 0; s < 4; ++s) qf[s] = *(const bf16x8*)(qp + 16 * s);
    const int n_hi = u0 >> 5; int n_lo = n_hi - 4; if (n_lo < 0) n_lo = 0;
    const size_t kvrow0 = (size_t)b * 8192 + (size_t)rg * SG;
    const LAS unsigned char* vtr0 = wl + (4 * h + ((lane & 15) >> 2)) * VPITCH + (16 * ((lane >> 4) & 1) + 4 * (lane & 3)) * 2;
    const bf16* kbase = Kb + (kvrow0 + c) * 768 + colb + 8 * h;
    const bf16* vbase = Vb + (kvrow0 + (lane >> 1)) * 768 + colb + 32 * (lane & 1);
#define ATT_LOAD(KF, VV, nn) do { const bf16* kp_ = kbase + (size_t)(nn) * (32 * 768); const bf16* vp_ = vbase + (size_t)(nn) * (32 * 768); \
        _Pragma("unroll") for (int s_ = 0; s_ < 4; ++s_) KF[s_] = *(const bf16x8*)(kp_ + 16 * s_); \
        _Pragma("unroll") for (int i_ = 0; i_ < 4; ++i_) VV[i_] = *(const v4u*)(vp_ + 8 * i_); } while (0)
    AttState st; st.m = -1e30f; st.l = 0.f; st.o0 = (f32x16){}; st.o1 = (f32x16){};
    bf16x8 kfA[4], kfB[4]; v4u vvA[4], vvB[4];
    ATT_LOAD(kfA, vvA, n_lo);
    for (int n = n_lo;;) {
        { const int nn = n + 1 < n_hi ? n + 1 : n_hi; ATT_LOAD(kfB, vvB, nn); }
        att_tile(!(n < n_hi && n > n_hi - 4), st, kfA, vvA, qf, n, uq, slope2, wl, vtr0, lane);
        if (n == n_hi) break; ++n;
        { const int nn = n + 1 < n_hi ? n + 1 : n_hi; ATT_LOAD(kfA, vvA, nn); }
        att_tile(!(n < n_hi && n > n_hi - 4), st, kfB, vvB, qf, n, uq, slope2, wl, vtr0, lane);
        if (n == n_hi) break; ++n;
    }
#undef ATT_LOAD
    LAS float* wsf = (LAS float*)(wl + ATT_WSF);
    const float lt = st.l + __shfl_xor(st.l, 32);
    const float lsej = st.m + __builtin_amdgcn_logf(lt);
    const int tlq = tl0 + ts * c;
    if (FIRST) { if (h == 0) { wsf[c] = __builtin_amdgcn_rcpf(lt); lsea[tlq] = lsej; } }
    else if (h == 0) { const float lc = lsea[tlq], M = fmaxf(lc, lsej), wc = __builtin_amdgcn_exp2f(lc - M), wj = __builtin_amdgcn_exp2f(lsej - M), is = __builtin_amdgcn_rcpf(wc + wj);
        wsf[c] = wc * is; wsf[32 + c] = wj * is * __builtin_amdgcn_rcpf(lt); lsea[tlq] = M + __builtin_amdgcn_logf(wc + wj); }
    asm volatile("s_waitcnt lgkmcnt(0)" ::: "memory");
#pragma unroll
    for (int r = 0; r < 16; ++r) { const int q = crow(r, h); LAS bf16* cp = comb + (tl0 + ts * q) * 64 + c;
        if (FIRST) { const float inv = wsf[q]; cp[0] = (bf16)f2bf(st.o0[r] * inv); cp[32] = (bf16)f2bf(st.o1[r] * inv); }
        else { const float wa = wsf[q], wb = wsf[32 + q]; const float c0 = __uint_as_float((unsigned)cp[0] << 16), c1 = __uint_as_float((unsigned)cp[32] << 16);
            cp[0] = (bf16)f2bf(c0 * wa + st.o0[r] * wb); cp[32] = (bf16)f2bf(c1 * wa + st.o1[r] * wb); } }
    asm volatile("s_waitcnt lgkmcnt(0)" ::: "memory");
}
__device__ __forceinline__ void att_unit2(const bf16* Q, const bf16* Kb, const bf16* Vb, bf16* OB, int b, int slot, int sp, LAS unsigned char* lds, int tid) {
    const int lane = tid & 63, wave = __builtin_amdgcn_readfirstlane(tid >> 6);
    LAS unsigned char* wl = lds + wave * ATT2_WAVE_BYTES; LAS bf16* comb = (LAS bf16*)(lds + ATT2_COMB); LAS float* lsea = (LAS float*)(lds + ATT2_LSE);
#pragma unroll 1
    for (int jj = 0; jj < 2; ++jj) att_job2<2, true>(Q, Kb, Vb, b, slot, sp, wave + 8 * jj, wl, comb, lsea, lane);
    __syncthreads();
#pragma unroll 1
    for (int jj = 0; jj < 2; ++jj) att_job2<1, false>(Q, Kb, Vb, b, slot, sp, 4 * (2 * (wave >> 2) + jj) + (wave & 3), wl, comb, lsea, lane);
    __syncthreads();
#pragma unroll 1
    for (int jj = 0; jj < 2; ++jj) att_job2<0, false>(Q, Kb, Vb, b, slot, sp, 2 * wave + jj, wl, comb, lsea, lane);
    __syncthreads();
#pragma unroll
    for (int ps = 0; ps < 8; ++ps) { const int row = ps * 64 + (tid >> 3), ch = tid & 7;
        const v4u v = *(const LAS v4u*)(comb + row * 64 + ch * 8);
        *(v4u*)(OB + ((size_t)b * 8192 + 512 * sp + row) * 768 + 512 + 64 * slot + ch * 8) = v; }
    __syncthreads();
}

constexpr int CONV_ROWS = 94, CONV_CBUF_OFF = 96256;
static_assert(CONV_CBUF_OFF + 32 * 512 * 2 <= RING_BYTES, "conv LDS");
__device__ __forceinline__ void conv_tile(const bf16* U, bf16* CB, const float* w_dw, const float* b_dw, const float* ln_g, const float* ln_b, int b, int t0, LAS unsigned char* lds, int tid) {
    const int lane = tid & 63, wave = tid >> 6;
    LAS bf16* us = (LAS bf16*)lds;
    { v4u stg[12];
#pragma unroll
        for (int k = 0; k < 12; ++k) { const int j = wave + NWAVES * k, t = t0 - 30 + j; stg[k] = (v4u){0u, 0u, 0u, 0u};
            if (j < CONV_ROWS && t >= 0) stg[k] = *(const v4u*)(U + ((size_t)b * 8192 + t) * 512 + lane * 8); }
#pragma unroll
        for (int k = 0; k < 12; ++k) { const int j = wave + NWAVES * k; if (j < CONV_ROWS) *(LAS v4u*)(us + j * 512 + lane * 8) = stg[k]; } }
    __syncthreads();
    const int cp = tid & 255, th = tid >> 8;
    typedef float f2v __attribute__((ext_vector_type(2)));
    f2v wv[31];
    const float* wp = w_dw + 2 * cp; asm volatile("" : "+v"(wp));
#pragma unroll
    for (int k = 0; k < 31; ++k) wv[k] = *(const f2v*)(wp + k * 512);
    const f2v bias = *(const f2v*)(b_dw + 2 * cp);
    LAS bf16* cbuf = (LAS bf16*)(lds + CONV_CBUF_OFF);
#pragma unroll 1
    for (int pass = 0; pass < 2; ++pass) {
        const int tb = th * 32 + pass * 16;
        f2v a[16];
#pragma unroll
        for (int i = 0; i < 16; ++i) a[i] = bias;
#pragma unroll
        for (int j = 0; j < 46; ++j) { const unsigned xv = *(const LAS unsigned*)(us + (tb + j) * 512 + 2 * cp); const f2v x = (f2v){bflo(xv), bfhi(xv)};
#pragma unroll
            for (int i = 0; i < 16; ++i) if (j - i >= 0 && j - i <= 30) a[i] = __builtin_elementwise_fma(wv[j - i], x, a[i]);
            if ((j & 7) == 7) asm volatile("" ::: "memory"); }
#pragma unroll
        for (int i = 0; i < 16; ++i) *(LAS unsigned*)(cbuf + (th * 16 + i) * 512 + 2 * cp) = pk2(a[i].x, a[i].y);
        __syncthreads();
#pragma unroll
        for (int q = 0; q < 4; ++q) { const int rb = 4 * wave + q, tok = (rb >> 4) * 32 + pass * 16 + (rb & 15);
            const v4u w = *(const LAS v4u*)(cbuf + rb * 512 + lane * 8);
            float v[8] = {bflo(w.x), bfhi(w.x), bflo(w.y), bfhi(w.y), bflo(w.z), bfhi(w.z), bflo(w.w), bfhi(w.w)};
            float s1 = 0.f, s2 = 0.f;
#pragma unroll
            for (int e = 0; e < 8; ++e) { s1 += v[e]; s2 += v[e] * v[e]; }
            s1 = wave_sum(s1); s2 = wave_sum(s2);
            const float mean = s1 * (1.f / 512.f), var = s2 * (1.f / 512.f) - mean * mean, rstd = __builtin_amdgcn_rsqf(var + EPS);
            const f32x4 g0 = *(const f32x4*)(ln_g + lane * 8), g1 = *(const f32x4*)(ln_g + lane * 8 + 4), b0 = *(const f32x4*)(ln_b + lane * 8), b1 = *(const f32x4*)(ln_b + lane * 8 + 4);
#pragma unroll
            for (int e = 0; e < 8; ++e) { const float y = (v[e] - mean) * rstd * (e < 4 ? g0[e] : g1[e - 4]) + (e < 4 ? b0[e] : b1[e - 4]); v[e] = y * fsig(y); }
            v4u o; o.x = pk2(v[0], v[1]); o.y = pk2(v[2], v[3]); o.z = pk2(v[4], v[5]); o.w = pk2(v[6], v[7]);
            *(v4u*)(CB + ((size_t)b * 8192 + t0 + tok) * 768 + lane * 8) = o; }
        __syncthreads();
    }
}
__device__ __forceinline__ void conv_sample(const bf16* U, bf16* CB, const float* state, const float* w_dw, const float* b_dw, const float* ln_g, const float* ln_b, int bs, LAS unsigned char* lds, int tid) {
    const int lane = tid & 63, wave = tid >> 6, ch = tid;
    float x[34];
#pragma unroll
    for (int j = 0; j < 30; ++j) x[j] = state[((size_t)bs * 30 + j) * 512 + ch];
#pragma unroll
    for (int j = 0; j < 4; ++j) x[30 + j] = __uint_as_float((unsigned)U[((size_t)MP + bs * 4 + j) * 512 + ch] << 16);
    float a[4]; const float bias = b_dw[ch];
#pragma unroll
    for (int i = 0; i < 4; ++i) a[i] = bias;
#pragma unroll
    for (int k = 0; k < 31; ++k) { const float w = w_dw[k * 512 + ch];
#pragma unroll
        for (int i = 0; i < 4; ++i) a[i] += w * x[i + k]; }
    LAS float* red = (LAS float*)lds;
#pragma unroll
    for (int i = 0; i < 4; ++i) { const float s1 = wave_sum(a[i]), s2 = wave_sum(a[i] * a[i]); if (lane == 0) { red[(i * 8 + wave) * 2] = s1; red[(i * 8 + wave) * 2 + 1] = s2; } }
    __syncthreads();
    const float g = ln_g[ch], be = ln_b[ch];
#pragma unroll
    for (int i = 0; i < 4; ++i) { float s1 = 0.f, s2 = 0.f;
#pragma unroll
        for (int w = 0; w < 8; ++w) { s1 += red[(i * 8 + w) * 2]; s2 += red[(i * 8 + w) * 2 + 1]; }
        const float mean = s1 * (1.f / 512.f), var = s2 * (1.f / 512.f) - mean * mean, rstd = __builtin_amdgcn_rsqf(var + EPS);
        float y = (a[i] - mean) * rstd * g + be; y *= fsig(y);
        CB[((size_t)MP + bs * 4 + i) * 768 + ch] = (bf16)f2bf(y); }
    __syncthreads();
}
__device__ __forceinline__ const float* samp_row(const float* c0, const float* c1, const float* c2, const float* out, int e, int bs, int tok, float& bias2, int slot) {
    const int g = e >= 258 ? 2 : e >= 129 ? 1 : 0, j = e - 129 * g, sh = 2 * g, W = 128 << sh, idx = W + tok - (j << sh);
    const float* cg = (g == 0) ? c0 : (g == 1) ? c1 : c2;
    const float* og = out + ((g == 0) ? O_KV0S : (g == 1) ? O_KV1S : O_KV2S);
    bias2 = __builtin_amdgcn_exp2f(-8.0f * (float)(4 * g + slot + 1) / 12.0f) * 1.4426950408889634f * (float)(j << sh);
    return (idx >= W) ? og + ((size_t)bs * W + (idx - 4)) * 512 + slot * 64 : cg + ((size_t)bs * W + idx) * 512 + slot * 64;
}
__device__ __forceinline__ float row16_sum(float v) { v += DPPF(v, 0xB1); v += DPPF(v, 0x4E); v += DPPF(v, 0x141); v += DPPF(v, 0x140); return v; }
__device__ __forceinline__ void att_sample_wave(const bf16* Q, bf16* OB, const float* c0, const float* c1, const float* c2, const float* out, int bs, int tok, int slot, int lane) {
    const int kq = lane >> 4, i4 = (lane & 15) * 4;
    const size_t qrow = (size_t)MP + bs * 4 + tok;
    f32x4 q4[3];
#pragma unroll
    for (int g = 0; g < 3; ++g) { const uint2 w = *(const uint2*)(Q + qrow * 768 + 256 * g + 64 * slot + i4); q4[g] = (f32x4){bflo(w.x), bfhi(w.x), bflo(w.y), bfhi(w.y)}; }
    float m = -1e30f, l = 0.f; f32x4 acc = (f32x4){0.f, 0.f, 0.f, 0.f};
    f32x4 kvA[8], vvA[8], kvB[8], vvB[8]; float b2A[8], b2B[8];
#define SAMP_LOAD(KV, VV, B2, S0) do { _Pragma("unroll") for (int t = 0; t < 8; ++t) { const int e = 4 * ((S0) + t) + kq, ec = e < 387 ? e : 386; \
            const float* rp = samp_row(c0, c1, c2, out, ec, bs, tok, B2[t], slot) + i4; KV[t] = *(const f32x4*)rp; VV[t] = *(const f32x4*)(rp + 256); } } while (0)
#define SAMP_STEP(KV, VV, B2, S0) do { _Pragma("unroll") for (int t = 0; t < 8; ++t) { const int e = 4 * ((S0) + t) + kq; \
            const f32x4 qq = e >= 258 ? q4[2] : e >= 129 ? q4[1] : q4[0]; \
            const float d = row16_sum((qq[0] * KV[t][0] + qq[1] * KV[t][1]) + (qq[2] * KV[t][2] + qq[3] * KV[t][3])); \
            const float sv = e < 387 ? d - B2[t] : -INFINITY; \
            const float mnew = fmaxf(m, sv), f = __builtin_amdgcn_exp2f(m - mnew), p = __builtin_amdgcn_exp2f(sv - mnew); \
            l = l * f + p; m = mnew; acc = acc * f + VV[t] * p; } } while (0)
    SAMP_LOAD(kvA, vvA, b2A, 0);
#pragma unroll 1
    for (int s0 = 0; s0 < 104; s0 += 16) {
        if (s0 + 8 < 104) SAMP_LOAD(kvB, vvB, b2B, s0 + 8);
        SAMP_STEP(kvA, vvA, b2A, s0);
        if (s0 + 8 >= 104) break;
        if (s0 + 16 < 104) SAMP_LOAD(kvA, vvA, b2A, s0 + 16);
        SAMP_STEP(kvB, vvB, b2B, s0 + 8);
    }
#undef SAMP_LOAD
#undef SAMP_STEP
    float M = fmaxf(m, __shfl_xor(m, 16)); M = fmaxf(M, __shfl_xor(M, 32));
    const float gsc = __builtin_amdgcn_exp2f(m - M);
    l *= gsc; acc = acc * gsc;
    l += __shfl_xor(l, 16); l += __shfl_xor(l, 32);
#pragma unroll
    for (int e = 0; e < 4; ++e) { acc[e] += __shfl_xor(acc[e], 16); acc[e] += __shfl_xor(acc[e], 32); }
    if (kq == 0) { const float inv = __builtin_amdgcn_rcpf(l);
        uint2 w; w.x = pk2(acc[0] * inv, acc[1] * inv); w.y = pk2(acc[2] * inv, acc[3] * inv);
        *(uint2*)(OB + qrow * 768 + 512 + 64 * slot + i4) = w; }
}
__device__ __forceinline__ void sub_barrier(gu32* cnt, unsigned target, bool arrive = true) {
    asm volatile("s_waitcnt vmcnt(0)" ::: "memory");
    __syncthreads();
    if (threadIdx.x == 0) {
        __builtin_amdgcn_fence(__ATOMIC_RELEASE, "agent");
        asm volatile("s_waitcnt vmcnt(0)" ::: "memory");
        if (arrive) __hip_atomic_fetch_add(cnt, 1u, RLX_AGENT);
        unsigned sp = 0;
        while (__hip_atomic_load(cnt, RLX_AGENT) < target) { __builtin_amdgcn_s_sleep(1); if (++sp > (1u << 22)) break; }
        __builtin_amdgcn_fence(__ATOMIC_ACQUIRE, "agent");
        asm volatile("s_waitcnt vmcnt(0)" ::: "memory");
    }
    __syncthreads();
}

__device__ __forceinline__ void kv_copy(const float* cache0, const float* cache1, const float* cache2, const float* state_conv, float* out, unsigned gt, unsigned GS) {
#pragma unroll
    for (int g = 0; g < 3; ++g) {
        const unsigned W = 128u << (2 * g); const float* cg = g == 0 ? cache0 : g == 1 ? cache1 : cache2;
        float* og = out + (g == 0 ? O_KV0S : g == 1 ? O_KV1S : O_KV2S);
        const unsigned per4 = (W - 4) * 128, tot4 = per4 * 32;
        for (unsigned i0 = gt; i0 < tot4; i0 += 8 * GS) {
            f32x4 v[8];
#pragma unroll
            for (int k = 0; k < 8; ++k) { const unsigned i = i0 + k * GS; if (i < tot4) { const unsigned bs = i / per4, r = i - bs * per4;
                v[k] = __builtin_nontemporal_load((const f32x4*)(cg + ((size_t)bs * W + 4) * 512) + r); } }
#pragma unroll
            for (int k = 0; k < 8; ++k) { const unsigned i = i0 + k * GS; if (i < tot4) { const unsigned bs = i / per4, r = i - bs * per4;
                __builtin_nontemporal_store(v[k], (f32x4*)(og + (size_t)bs * W * 512) + r); } }
        }
    }
    const unsigned per4 = 26 * 128, tot4 = per4 * 32;
    for (unsigned i = gt; i < tot4; i += GS) { const unsigned bs = i / per4, r = i - bs * per4;
        ((f32x4*)(out + O_CONVS + (size_t)bs * 30 * 512))[r] = ((const f32x4*)(state_conv + ((size_t)bs * 30 + 4) * 512))[r]; }
}
#define WS_PTRS(ws) \
    float* rstd0 = (float*)(ws + WS_RSTD0); float* ssq1 = (float*)(ws + WS_SSQ1); float* ssq2 = (float*)(ws + WS_SSQ2); float* ssq3 = (float*)(ws + WS_SSQ3); \
    bf16* Wi_t = (bf16*)(ws + WS_W_IN); bf16* Wm_t = (bf16*)(ws + WS_W_C); bf16* Wo_t = (bf16*)(ws + WS_W_O); \
    bf16* Wu_t = (bf16*)(ws + WS_W_UP); bf16* Wd_t = (bf16*)(ws + WS_W_DN); bf16* Wg_t = (bf16*)(ws + WS_W_PG); bf16* Wp_t = (bf16*)(ws + WS_W_PL); \
    bf16* PB = (bf16*)(ws + WS_PB); bf16* XB = (bf16*)(ws + WS_XB); bf16* CO = (bf16*)(ws + WS_CO); \
    bf16* U = (bf16*)(ws + WS_U); bf16* Qb = (bf16*)(ws + WS_Q); bf16* Kb = (bf16*)(ws + WS_K); bf16* Vb = (bf16*)(ws + WS_V); \
    bf16* MIX = (bf16*)(ws + WS_MIX); bf16* HB = (bf16*)(ws + WS_H); bf16* GT = (bf16*)(ws + WS_GT); bf16* PP = (bf16*)(ws + WS_PP);
__global__ void __launch_bounds__(NTHREADS, 2) mega_fwd(Args args) {
    extern __shared__ __attribute__((aligned(16))) unsigned char lds_raw[];
    LAS unsigned char* lds = (LAS unsigned char*)lds_raw;
    volatile LAS unsigned* MISC = (volatile LAS unsigned*)(lds + MISC_OFF);
    const int tid0 = threadIdx.x; const int wave0 = __builtin_amdgcn_readfirstlane(tid0 >> 6);
    const int G = gridDim.x; const int bx = blockIdx.x; const int vcu = (G % 8 == 0) ? (bx % 8) * (G / 8) + bx / 8 : bx;
    unsigned char* ws = args.ws; float* out = args.out;
    gu32* ctl = (gu32*)(ws + WS_CTL);
    const float* x_prompt = args.in[0]; const float* x_sample = args.in[1]; const float* state_conv = args.in[2];
    const float* cache0 = args.in[3]; const float* cache1 = args.in[4]; const float* cache2 = args.in[5];
    const float* p_prompt = args.in[6]; const float* p_sample = args.in[7];
    const float* g_mix = args.in[8]; const float* w_in = args.in[9]; const float* w_dw = args.in[10]; const float* b_dw = args.in[11];
    const float* ln_g = args.in[12]; const float* ln_b = args.in[13]; const float* w_conv_out = args.in[14]; const float* w_att_out = args.in[15];
    const float* w_out = args.in[16]; const float* g_ffn = args.in[17]; const float* w_ffn_gate = args.in[18]; const float* w_ffn_up = args.in[19];
    const float* w_ffn_down = args.in[20]; const float* g_ple = args.in[21]; const float* w_ple_gate = args.in[22]; const float* w_ple = args.in[23];
    const float* g_final = args.in[24];
    for (int u = tid0; u < (LDS_BYTES - LDSCTL_OFF) / 4; u += NTHREADS) ((LAS unsigned*)(lds + LDSCTL_OFF))[u] = 0u;
    __syncthreads();
    XcdBarrier bar; bar.bar = (unsigned*)(ctl + CW_BAR); bar.x = 0; bar.st = nullptr; bar.gsize = 0u;
    if (N_LAUNCHES == 1) bar = xcd_barrier_post((unsigned*)(ctl + CW_BAR), MISC + 8);
    XcdBarrier gbar = xcd_barrier_post((unsigned*)(ctl + CW_GBAR) + (blockIdx.x & 15) * XCD_BAR_WORDS, MISC + 12); gbar.gsize = gridDim.x / 16;
    const bool is_smp = blockIdx.x < 32;
    XcdBarrier rbar = xcd_barrier_post((unsigned*)(ctl + (is_smp ? CW_SBAR : CW_PBAR)), MISC + 16); rbar.gsize = is_smp ? 32u : gridDim.x - 32u;
#define ROLE_BAR() do { XcdBarrier b4_ = rbar; asm volatile("" : "+s"(b4_.bar)); xcd_barrier(b4_); } while (0)
#define GROUP_BAR() do { XcdBarrier b3_ = gbar; asm volatile("" : "+s"(b3_.bar)); xcd_barrier(b3_); } while (0)
#define GRID_BAR() do { if (N_LAUNCHES == 1) { XcdBarrier b2_ = bar; asm volatile("" : "+s"(b2_.bar)); xcd_barrier(b2_); } } while (0)
    const int lo = args.ph_lo, hi = args.ph_hi;
#ifdef PROBE_TS
    unsigned long long* tsw = (unsigned long long*)(ctl + 12288); int nstamp = 0;
#ifndef TS_BLOCK
#define TS_BLOCK 0
#endif
#define STAMP() do { if (bx == TS_BLOCK && wave0 == 0 && __builtin_amdgcn_mbcnt_hi(~0u, __builtin_amdgcn_mbcnt_lo(~0u, 0u)) == 0) tsw[nstamp] = __builtin_amdgcn_s_memrealtime(); ++nstamp; } while (0)
#else
#define STAMP() do {} while (0)
#endif
    STAMP();
#ifndef PH_MASK
#define PH_MASK 0x1ff
#endif
#define IN(k) ((((PH_MASK) >> (k)) & 1) && lo <= (k) && (k) < hi)
#define BOTH(k) (IN(k) && IN((k) + 1))
#ifndef PROBE_DBL
#define PROBE_DBL 0
#endif
#ifndef ATT_REP
#define ATT_REP 1
#endif
#ifndef CONV_REP
#define CONV_REP 1
#endif
#ifndef SAMP_REP
#define SAMP_REP 1
#endif
#ifndef W_REP
#define W_REP 1
#endif
#ifndef ROW_REP
#define ROW_REP 1
#endif
#ifndef COPY_REP
#define COPY_REP 1
#endif
#ifndef PPB_PANELS
#define PPB_PANELS 64
#endif
#ifndef SKIP_MASK
#define SKIP_MASK 0
#endif
#define NREP(k) ((((PROBE_DBL) >> (k)) & 1) ? 2 : 1)
    const int NGW = G * NWAVES; constexpr int NSWG = 32, CW_GRP = 8448, CW_SB = 8192, CW_PG = 8320, CW_Q = 8384, CW_TMO2 = 8256, CW_PCNT = 16384, LASTPH = 7;
#define PH_IDS() unsigned z_ = 0u; asm volatile("" : "+s"(z_)); int tid_ = wave0 * 64 + (int)__builtin_amdgcn_mbcnt_hi(~0u, __builtin_amdgcn_mbcnt_lo(~0u, z_)); asm volatile("" : "+v"(tid_)); const int tid = tid_, lane = tid & 63, wave = __builtin_amdgcn_readfirstlane(tid >> 6), gw = vcu * NWAVES + wave; (void)lane; (void)gw

    constexpr int I_IN = 16 * (NIN / 32), I_C = 8 * 32, I_A = 4 * 32, I_O = 16 * 32, I_U = 16 * (2 * DFF / 32), I_D = (DFF / 64) * 32, I_G = 16 * 32, I_P = 4 * 32;
    constexpr int NITEMS = I_IN + I_C + I_A + I_O + I_U + I_D + I_G + I_P;
#define W_ITEM(it_) do { int r = (it_); \
        if (r < I_IN) { const int nblk = NIN / 32, kb = r / nblk, nb = r % nblk, R = 32 * nb, pn = R >> 8, cc = R & 255; \
            const int csrc = pn < 4 ? (cc < 128 ? 128 * pn + cc : 512 + 128 * pn + (cc - 128)) : pn < 13 ? R : (cc < 128 ? 3328 + 128 * (pn - 13) + cc : 4352 + 128 * (pn - 13) + (cc - 128));   \
            p0_transpose_item(w_in, NIN, 64 * kb, csrc, Wi_t, 1024, R, g_mix, scr, lane); } \
        else if ((r -= I_IN) < I_C) { p0_mat_item(w_conv_out, 512, 1024, 0, 1024, Wm_t, 768, 0, nullptr, scr, r, lane); } \
        else if ((r -= I_C) < I_A) { p0_mat_item(w_att_out, 256, 1024, 0, 1024, Wm_t, 768, 0, nullptr, scr, r, lane, 512); } \
        else if ((r -= I_A) < I_O) { p0_mat_item(w_out, 1024, 1024, 0, 1024, Wo_t, 1024, 0, nullptr, scr, r, lane); } \
        else if ((r -= I_O) < I_U) { const int nblk = 2 * DFF / 32, kb = r / nblk, nb = r % nblk, R = 32 * nb, pn = R >> 8, cc = R & 255; \
            const float* src = cc < 128 ? w_ffn_gate : w_ffn_up; const int csrc = 128 * pn + (cc & 127); \
            p0_transpose_item(src, DFF, 64 * kb, csrc, Wu_t, 1024, R, g_ffn, scr, lane); } \
        else if ((r -= I_U) < I_D) { p0_mat_item(w_ffn_down, DFF, 1024, 0, 1024, Wd_t, DFF, 0, nullptr, scr, r, lane); } \
        else if ((r -= I_D) < I_G) { p0_mat_item(w_ple_gate, 1024, 1024, 0, 1024, Wg_t, 1024, 0, g_ple, scr, r, lane); } \
        else { r -= I_G; p0_mat_item(w_ple, 256, 1024, 0, 1024, Wp_t, 256, 0, nullptr, scr, r, lane); } } while (0)
    if (IN(0)) for (int rep_ = 0; rep_ < NREP(0); ++rep_) {
        PH_IDS();
        unsigned char* wsl = ws; asm volatile("" : "+s"(wsl)); WS_PTRS(wsl)
        LAS float* scr = (LAS float*)(lds + wave * 16384);
        for (int j = gw; j < I_IN + I_P; j += NGW) { W_ITEM(j < I_IN ? j : (NITEMS - I_P) + (j - I_IN)); }
        for (int r2_ = 0; r2_ < ROW_REP; ++r2_)
        for (int m = gw; m < MPAD; m += NGW) {
            GAS unsigned long long* xo = (GAS unsigned long long*)(XB + (size_t)m * 1024) + lane;
            GAS unsigned long long* po = (GAS unsigned long long*)(PB + (size_t)m * 256) + lane;
            if (m < MR) {
                const float* xr = m < MP ? x_prompt + (size_t)m * 1024 : x_sample + (size_t)(m - MP) * 1024;
                const float* pr = m < MP ? p_prompt + (size_t)m * 256 : p_sample + (size_t)(m - MP) * 256;
                f32x4 v[4]; float s = 0.f;
#pragma unroll
                for (int j = 0; j < 4; ++j) { v[j] = ((const GAS f32x4*)xr)[lane + 64 * j]; s += (v[j][0] * v[j][0] + v[j][1] * v[j][1]) + (v[j][2] * v[j][2] + v[j][3] * v[j][3]); }
                const f32x4 pv = ((const GAS f32x4*)pr)[lane];
                s = wave_sum(s);
                if (lane == 0) rstd0[m] = __builtin_amdgcn_rsqf(s * (1.f / 1024.f) + EPS);
#pragma unroll
                for (int j = 0; j < 4; ++j) xo[64 * j] = (unsigned long long)pk2(v[j][0], v[j][1]) | ((unsigned long long)pk2(v[j][2], v[j][3]) << 32);
                po[0] = (unsigned long long)pk2(pv[0], pv[1]) | ((unsigned long long)pk2(pv[2], pv[3]) << 32);
            } else {
                if (lane == 0) rstd0[m] = 0.f;
#pragma unroll
                for (int j = 0; j < 4; ++j) xo[64 * j] = 0ull;
                po[0] = 0ull;
            }
        }
        if (BOTH(0) || rep_ + 1 < NREP(0)) GRID_BAR();
    }
    STAMP();

    enum { MODE_S = 0, MODE_PS = 1, MODE_ALL = 2, MODE_GA = 3, MODE_GB = 4 };
    const int grp = (bx >> 3) & 1, cg = bx >> 4; unsigned ggen = 0;
    int mode = (bx < NSWG) ? MODE_S : MODE_PS, phase = (bx < NSWG) ? 0 : 1; unsigned sbgen = 0; bool rep_done = false;
    gu32* sbcnt = ctl + CW_SB;
#ifdef PROBE_TS2
    if (bx == 0 && wave0 == 0 && __builtin_amdgcn_mbcnt_hi(~0u, __builtin_amdgcn_mbcnt_lo(~0u, 0u)) == 0) ((unsigned long long*)(ctl + 12288))[32] = __builtin_amdgcn_s_memrealtime();
#endif
    for (;;) {
        unsigned char* wsl = ws; asm volatile("" : "+s"(wsl)); WS_PTRS(wsl)
        int pm0, nMt, Gm, cm, vcm;
        bf16 *COm = CO, *MIXm = MIX, *HBm = HB;
        if (mode == MODE_S) { pm0 = MP / 256; nMt = 1; Gm = NSWG; cm = bx; vcm = bx;
            COm = (bf16*)(wsl + WS_SMP_CO) - (size_t)MP * 768; MIXm = (bf16*)(wsl + WS_SMP_MIX) - (size_t)MP * 1024;
            HBm = (bf16*)(wsl + WS_SMP_H) - (size_t)MP * DFF; }
        else if (mode == MODE_PS) { pm0 = 0; nMt = MP / 256; Gm = G - NSWG; cm = bx - NSWG; vcm = cm; }
        else if (mode == MODE_ALL) { pm0 = 0; nMt = MP / 256; Gm = G; cm = bx; vcm = vcu; }
        else { pm0 = 8 * (bx & 7) + ((mode == MODE_GB) ? 64 : 0); nMt = 8; Gm = G / 16; cm = cg; vcm = cg; }
        const bool p4 = (mode == MODE_GA || mode == MODE_GB);
        const int ph = (phase == 3 && ((mode == MODE_PS) || (mode == MODE_S && cm >= 4 && cm < 8))) ? 8 : (mode == MODE_S && ((phase == 3 && cm >= 8) || (phase == 4 && cm >= 4))) ? 9 : phase;
        switch (ph) {
        case 0: {
            PH_IDS(); LAS float* scr = (LAS float*)(lds + wave * 16384);
            for (int j = I_IN + cm * NWAVES + wave; j < I_IN + I_C + I_A; j += NSWG * NWAVES) { W_ITEM(j); }
        } break;
        case 9: {
            PH_IDS(); LAS float* scr = (LAS float*)(lds + wave * 16384);
            const int w0 = (phase == 3) ? 8 : 4, jlo = (phase == 3) ? I_IN + I_C + I_A : I_IN + I_C + I_A + I_O + I_U, jhi = (phase == 3) ? I_IN + I_C + I_A + I_O + I_U : NITEMS - I_P;
            for (int j = jlo + (cm - w0) * NWAVES + wave; j < jhi; j += (NSWG - w0) * NWAVES) { W_ITEM(j); }
        } break;
        case 1: if (!((SKIP_MASK >> 1) & 1)) {
            pg8::Gemm g{XB, Wi_t, MPAD, NIN, 1024, 1024}; pg8::RangeOrder S; S.init(pm0, nMt, NIN, Gm, cm);
            pg8::EpiIn E{rstd0, U, Qb, Kb, Vb, GT, out};
            pg8::gemm_phase<pg8::EpiIn, pg8::RangeOrder, true, true>(lds, g, S, E, wave0);
        } break;
        case 2: if (!((SKIP_MASK >> 2) & 1)) {
            PH_IDS();
            if (mode == MODE_S) {
                conv_sample(U, COm, state_conv, w_dw, b_dw, ln_g, ln_b, cm, lds, tid);
#pragma unroll 1
                for (int r = 0; r < 2; ++r) { const int j = cm * 16 + r * 8 + wave;
#ifndef NO_SAMPATT
                    att_sample_wave(Qb, COm, cache0, cache1, cache2, out, j >> 4, (j >> 2) & 3, j & 3, lane);
#endif
                }
            } else {
#ifndef QPP
#define QPP 32
#endif
                LAS int* qit = (LAS int*)(lds + LDSCTL_OFF + 64);
                for (;;) {
                    __syncthreads();
                    if (tid == 0) qit[0] = (int)__hip_atomic_fetch_add(ctl + CW_Q, 1u, RLX_AGENT);
                    __syncthreads();
                    const int it = __builtin_amdgcn_readfirstlane(qit[0]);
                    if (it >= 768 + QPP) break;
                    unsigned zq_ = 0u; asm volatile("" : "+s"(zq_)); int tq = wave0 * 64 + (int)__builtin_amdgcn_mbcnt_hi(~0u, __builtin_amdgcn_mbcnt_lo(~0u, zq_)); asm volatile("" : "+v"(tq));
#ifdef PROBE_Q
                    const unsigned long long q0_ = __builtin_amdgcn_s_memrealtime();
#endif
                    if (it < 256) {
                        int b_, slot_, sp_; if (it < 240) { b_ = it / 60; const int r_ = it - 60 * b_; slot_ = r_ / 15; sp_ = 1 + (r_ - 15 * slot_); } else { b_ = (it - 240) >> 2; slot_ = (it - 240) & 3; sp_ = 0; }
                        att_unit2(Qb, Kb, Vb, COm, b_, slot_, sp_, lds, tq); }
                    else if (it < 768) { const int ti = it - 256; conv_tile(U, COm, w_dw, b_dw, ln_g, ln_b, ti >> 7, (ti & 127) * 64, lds, tq); }
                    else {
                        const int pu = it - 768; int kq = 256; asm volatile("" : "+s"(kq));
                        pg8::Gemm gq{PB, Wp_t, MPAD, 1024, kq, kq}; pg8::RangeOrder Sq; Sq.init(64 - QPP / 4 + (pu >> 2), 1, 1024, 4, pu & 3); pg8::EpiGate Eq{nullptr, 0, PP};
                        pg8::gemm_phase<pg8::EpiGate, pg8::RangeOrder, true, true>(lds, gq, Sq, Eq, wave0); }
#ifdef PROBE_Q
                    asm volatile("s_waitcnt vmcnt(0)" ::: "memory");
                    if (bx == TS_BLOCK && wave0 == 0 && __builtin_amdgcn_mbcnt_hi(~0u, __builtin_amdgcn_mbcnt_lo(~0u, 0u)) == 0) { const int sl_ = it < 256 ? 21 : 20; if (tsw[sl_] == 0) tsw[sl_] = __builtin_amdgcn_s_memrealtime() - q0_; }
#endif
                }
            }
        } break;
        case 3: if (!((SKIP_MASK >> 3) & 1)) {
            int k3 = 768; asm volatile("" : "+s"(k3));
            pg8::Gemm g{COm, Wm_t, MPAD, 1024, k3, k3}; pg8::RangeOrder S; S.init(pm0, nMt, 1024, Gm, cm, p4); pg8::EpiMix E{GT, MIXm};
            pg8::gemm_phase<pg8::EpiMix, pg8::RangeOrder, true, true>(lds, g, S, E, wave0);
        } break;
        case 8: {
            int k8 = 256; asm volatile("" : "+s"(k8));
            pg8::Gemm g{PB, Wp_t, MPAD, 1024, k8, k8}; pg8::RangeOrder S; S.init(pm0, mode == MODE_PS ? 64 - QPP / 4 : nMt, 1024, mode == MODE_S ? 4 : Gm, mode == MODE_S ? cm - 4 : cm, p4); pg8::EpiGate E{nullptr, 0, PP};
            pg8::gemm_phase<pg8::EpiGate, pg8::RangeOrder, true, true>(lds, g, S, E, wave0);
        } break;
        case 4: if (!((SKIP_MASK >> 4) & 1)) {
            pg8::Gemm g{MIXm, Wo_t, MPAD, 1024, 1024, 1024}; pg8::RangeOrder S; S.init(pm0, nMt, 1024, Gm, cm, p4); pg8::EpiResidIn E{x_prompt, x_sample, XB, ssq1};
            pg8::gemm_phase<pg8::EpiResidIn, pg8::RangeOrder, true, true>(lds, g, S, E, wave0);
        } break;
        case 5: if (!((SKIP_MASK >> 5) & 1)) {
            pg8::Gemm g{XB, Wu_t, MPAD, 2 * DFF, 1024, 1024}; pg8::RangeOrder S; S.init(pm0, nMt, 2 * DFF, Gm, cm, p4); pg8::EpiUp E{ssq1, HBm, cache0, cache1, cache2, state_conv, out};
            pg8::gemm_phase<pg8::EpiUp, pg8::RangeOrder, true, true>(lds, g, S, E, wave0);
#ifdef PROBE_NULLEPI
            if (mode == MODE_ALL) { GRID_BAR(); pg8::EpiNull E0{}; pg8::gemm_phase<pg8::EpiNull, pg8::RangeOrder, true, true>(lds, g, S, E0, wave0); }
#endif
        } break;
        case 6: if (!((SKIP_MASK >> 6) & 1)) {
            pg8::Gemm g{HBm, Wd_t, MPAD, 1024, DFF, DFF}; pg8::RangeOrder S; S.init(pm0, nMt, 1024, Gm, cm, p4); pg8::EpiResidB E{XB, ssq2};
            pg8::gemm_phase<pg8::EpiResidB, pg8::RangeOrder, true, true>(lds, g, S, E, wave0);
        } break;
        case 7: if (!((SKIP_MASK >> 7) & 1)) {
            { pg8::Gemm g{XB, Wg_t, MPAD, 1024, 1024, 1024}; pg8::RangeOrder S; S.init(pm0, nMt, 1024, Gm, cm, p4); pg8::EpiPleNorm E{ssq2, PP, XB, out, ssq3, (unsigned*)(ctl + CW_PCNT), g_final, (unsigned*)(ctl + CW_TMO2), (LAS float*)(lds + LDSCTL_OFF + 4096)};
              pg8::gemm_phase<pg8::EpiPleNorm, pg8::RangeOrder, true, true>(lds, g, S, E, wave0); }
        } break;
        default: break;
        }
#ifdef PROBE_TS2
        { const bool l0 = wave0 == 0 && __builtin_amdgcn_mbcnt_hi(~0u, __builtin_amdgcn_mbcnt_lo(~0u, 0u)) == 0; unsigned long long* t2 = (unsigned long long*)(ctl + 12288) + 32;
          asm volatile("s_waitcnt vmcnt(0)" ::: "memory");
          if (l0 && bx == 0 && mode == MODE_S) t2[phase] = __builtin_amdgcn_s_memrealtime();
          if (l0 && bx == 32 && mode == MODE_PS) t2[phase == 1 ? 8 : 9] = __builtin_amdgcn_s_memrealtime(); }
#endif
        if (mode == MODE_ALL) {
            STAMP(); GRID_BAR(); STAMP();
            if (grp) { mode = MODE_GB; phase = 8; } else { mode = MODE_GA; phase = 3; }
        } else if (mode == MODE_GA || mode == MODE_GB) {
            if (phase == 8) { phase = 3; continue; }
            if (phase == LASTPH) break;
            STAMP(); GROUP_BAR(); STAMP(); ++phase;
        } else if (mode == MODE_S) {
            if (phase == LASTPH) { sub_barrier(ctl + CW_PFLAG, 1u, false); STAMP(); mode = MODE_ALL; phase = 2; }
            else if (phase == 0) { __syncthreads(); phase = 1; continue; }
            else if (phase >= 6) { ++sbgen; sub_barrier(sbcnt, sbgen * 4u); ++phase; }
            else { ROLE_BAR();
                if (phase == 5 && cm >= 4) { sub_barrier(ctl + CW_PFLAG, 1u, false); STAMP(); mode = MODE_ALL; phase = 2; continue; }
#ifdef CHAIN_DBL
                if (((CHAIN_DBL >> phase) & 1) && !rep_done) { rep_done = true; continue; }
                rep_done = false;
#endif
                ++phase; }
        } else {
            if (phase == 1) { phase = 3; continue; }
            ROLE_BAR();
            if (cm == 0 && wave0 == 0 && __builtin_amdgcn_mbcnt_hi(~0u, __builtin_amdgcn_mbcnt_lo(~0u, 0u)) == 0) __hip_atomic_store(ctl + CW_PFLAG, 1u, RLX_AGENT);
            STAMP(); mode = MODE_ALL; phase = 2; }
    }
#ifdef PROBE_TS2
    GRID_BAR();
    if (bx == 0 && wave0 == 0 && __builtin_amdgcn_mbcnt_hi(~0u, __builtin_amdgcn_mbcnt_lo(~0u, 0u)) == 0) { unsigned long long* t2 = (unsigned long long*)(ctl + 12288) + 32; out[0] += (float)(((unsigned)(t2[PROBE_TS2] - t2[0]) + 500u) / 1000u) * 10.0f; }
#endif
#ifdef PROBE_TS
    GRID_BAR(); STAMP();
    if (bx == 0 && wave0 == 0 && __builtin_amdgcn_mbcnt_hi(~0u, __builtin_amdgcn_mbcnt_lo(~0u, 0u)) == 0) {
        unsigned long long d = tsw[PROBE_TS] - tsw[PROBE_TS - 1];
#ifdef PROBE_Q
        d = tsw[PROBE_Q];
#endif
#ifdef PROBE_TSUM
        d = 0; for (int k_ = 0; k_ < PROBE_TSUM; ++k_) d += tsw[PROBE_TS + 2 * k_] - tsw[PROBE_TS + 2 * k_ - 1];
#endif
        #ifndef PROBE_QUANT
#define PROBE_QUANT 500u
#endif
        out[0] += (float)(((unsigned)d + PROBE_QUANT / 2) / PROBE_QUANT) * (float)(PROBE_QUANT / 100u); }
#endif
#undef IN
#undef BOTH
#undef GRID_BAR
}

extern "C" void kernel_launch(void* const* d_in, const int* in_sizes, int n_in, void* d_out, int out_size, void* d_ws, size_t ws_size, hipStream_t stream) {
    static int grid = 0;
    if (grid == 0) {
        if (n_in != 25 || (size_t)out_size != O_END || ws_size < WS_END) { fprintf(stderr, "kernel_launch: shape mismatch: n_in %d out %d ws %zu (need %zu)\n", n_in, out_size, ws_size, (size_t)WS_END); grid = -1; return; }
        int dev = 0, cus = 0;
        if (hipGetDevice(&dev) != hipSuccess || hipDeviceGetAttribute(&cus, hipDeviceAttributeMultiprocessorCount, dev) != hipSuccess) { grid = -1; return; }
        if (hipFuncSetAttribute((const void*)mega_fwd, hipFuncAttributeMaxDynamicSharedMemorySize, LDS_BYTES) != hipSuccess) { fprintf(stderr, "kernel_launch: hipFuncSetAttribute failed\n"); grid = -1; return; }
        int per_cu = 0;
        if (hipOccupancyMaxActiveBlocksPerMultiprocessor(&per_cu, (const void*)mega_fwd, NTHREADS, LDS_BYTES) != hipSuccess || per_cu < 1) fprintf(stderr, "kernel_launch: occupancy query says %d\n", per_cu);
        (void)hipGetLastError();
        grid = cus;
    }
    if (grid < 0) return;
    (void)hipMemsetAsync((char*)d_ws + WS_CTL, 0, CTL_ZERO_BYTES, stream);
    Args a{};
    for (int i = 0; i < 25; ++i) a.in[i] = (const float*)d_in[i];
    a.out = (float*)d_out; a.ws = (unsigned char*)d_ws;
    if (N_LAUNCHES == 1) { a.ph_lo = 0; a.ph_hi = NPHASE; if (grid != 256) { fprintf(stderr, "kernel_launch: built for 256 CUs, got %d\n", grid); return; } hipLaunchKernelGGL(mega_fwd, dim3(grid), dim3(NTHREADS), LDS_BYTES, stream, a); }
    else {
#ifdef DBG_DUMP
        for (int li = 0; li <= DBG_DUMP; ++li) { a.ph_lo = li; a.ph_hi = li + 1; hipLaunchKernelGGL(mega_fwd, dim3(grid), dim3(NTHREADS), LDS_BYTES, stream, a); }
        if (DBG_DUMP == 1 || DBG_DUMP == 2 || DBG_DUMP == 3 || DBG_DUMP == 5) { a.ph_lo = 9; a.ph_hi = 10; hipLaunchKernelGGL(mega_fwd, dim3(grid), dim3(NTHREADS), LDS_BYTES, stream, a); }
#else
        for (int li = 0; li < NPHASE; ++li) { a.ph_lo = li; a.ph_hi = li + 1; hipLaunchKernelGGL(mega_fwd, dim3(grid), dim3(NTHREADS), LDS_BYTES, stream, a); }
#endif
    }
}
```

```cpp
#include <hip/hip_runtime.h>
#include <cstdio>
#include <cstdint>

namespace cfg {
constexpr int DM = 1024, SEQ = 8192, NBATCH = 4, MP = NBATCH * SEQ, NSEQ = 32, NTOK = 4, MS = NSEQ * NTOK, MR = MP + MS, MPAD = 33024;
constexpr int DCONV = 512, NIN = 5376, DFF = 2816, DPLE = 256, CWID = 31;
constexpr float EPS = 1e-6f;
constexpr float C2 = 0.125f * 1.4426950408889634f;
constexpr size_t O_Y = 0;
constexpr size_t O_CONVP = (size_t)MR * DM;
constexpr size_t O_CONVS = O_CONVP + (size_t)4 * 30 * 512;
constexpr size_t O_KV0P = O_CONVS + (size_t)32 * 30 * 512;
constexpr size_t O_KV0S = O_KV0P + (size_t)4 * 128 * 512;
constexpr size_t O_KV1P = O_KV0S + (size_t)32 * 128 * 512;
constexpr size_t O_KV1S = O_KV1P + (size_t)4 * 512 * 512;
constexpr size_t O_KV2P = O_KV1S + (size_t)32 * 512 * 512;
constexpr size_t O_KV2S = O_KV2P + (size_t)4 * 2048 * 512;
constexpr size_t O_END = O_KV2S + (size_t)32 * 2048 * 512;
static_assert(O_END == 83783680, "output size");
}
namespace pg8 {
#define PG8_LAS __attribute__((address_space(3)))
typedef unsigned short bf16_t;
typedef short bf16x8 __attribute__((ext_vector_type(8)));
typedef float f32x4 __attribute__((ext_vector_type(4)));
typedef unsigned u32x4 __attribute__((ext_vector_type(4)));
constexpr int BM = 256, BK = 64, HALF = 128, HTB = HALF * BK * 2  , STAGE_BYTES = 8 * HTB, NXCD = 8, WGM = 4;

__host__ __device__ __forceinline__ int lds_byte(int r, int c) { const int st = (r >> 4) * 2 + (c >> 5), rr = r & 15, cc = c & 31, ob = rr * 64 + cc * 2; return st * 1024 + (ob ^ (((ob >> 9) & 1) << 5)); }
__host__ __device__ __forceinline__ void stage_rc(int b, int& R, int& C) { const int st = b / 1024, sb = b % 1024, swz = sb ^ (((sb >> 9) & 1) << 5); R = (st >> 1) * 16 + swz / 64; C = (st & 1) * 32 + (swz % 64) / 2; }
__host__ __device__ __forceinline__ int perm32(int rho) { const int n = rho >> 4, i = rho & 15; return 8 * (i >> 2) + 4 * n + (i & 3); }

struct Unit { int pm, pn; };
struct Gemm { const bf16_t* A; const bf16_t* Bt; int M, N, K, ld; };

struct StaticOrder {
    int nM, nN, nwg, G, c;
    __host__ __device__ void init(int M, int N, int G_, int c_) { nM = M / BM; nN = N / BM; nwg = nM * nN; G = G_; c = c_; }
    __host__ __device__ bool next(int i, Unit& u) const {
        const long L = (long)i * G + c; if (L >= nwg) return false;
        int wgid = (int)L; { const int q = nwg / NXCD, r = nwg % NXCD, xcd = wgid % NXCD, off = wgid / NXCD; wgid = (xcd < r ? xcd * (q + 1) : r * (q + 1) + (xcd - r) * q) + off; }
        const int nig = WGM * nN, gid = wgid / nig, fm = gid * WGM, gsz = (nM - fm) < WGM ? (nM - fm) : WGM;
        u.pm = fm + ((wgid % nig) % gsz); u.pn = (wgid % nig) / gsz; return true;
    }
    __device__ __forceinline__ void a_ready(const Unit&) const {}
    __device__ __forceinline__ void done(const Unit&) const {}
};

typedef float f32x2c_t __attribute__((ext_vector_type(2))); typedef __bf16 bf16x2c_t __attribute__((ext_vector_type(2)));
__device__ __forceinline__ unsigned cvt_pk_bf16(float lo, float hi) { const f32x2c_t v = {lo, hi}; const bf16x2c_t b = __builtin_convertvector(v, bf16x2c_t); return __builtin_bit_cast(unsigned, b); }
typedef float f32x2 __attribute__((ext_vector_type(2)));
__device__ __forceinline__ float sigm(float x) { return __builtin_amdgcn_rcpf(1.0f + __builtin_amdgcn_exp2f(-1.4426950408889634f * x)); }
__device__ __forceinline__ u32x4 pack8(const f32x4 a, const f32x4 b) { u32x4 w; w.x = cvt_pk_bf16(a[0], a[1]); w.y = cvt_pk_bf16(a[2], a[3]); w.z = cvt_pk_bf16(b[0], b[1]); w.w = cvt_pk_bf16(b[2], b[3]); return w; }
__device__ __forceinline__ void unpack8(const u32x4 w, f32x4& a, f32x4& b) {
    a[0] = __uint_as_float(w.x << 16); a[1] = __uint_as_float(w.x & 0xffff0000u); a[2] = __uint_as_float(w.y << 16); a[3] = __uint_as_float(w.y & 0xffff0000u);
    b[0] = __uint_as_float(w.z << 16); b[1] = __uint_as_float(w.z & 0xffff0000u); b[2] = __uint_as_float(w.w << 16); b[3] = __uint_as_float(w.w & 0xffff0000u); }
__device__ __forceinline__ float dot4(const f32x4 a) { return (a[0] * a[0] + a[1] * a[1]) + (a[2] * a[2] + a[3] * a[3]); }
__device__ __forceinline__ float rstd16(const float* p) {
    const f32x4 a = *(const f32x4*)p, b = *(const f32x4*)(p + 4), c = *(const f32x4*)(p + 8), d = *(const f32x4*)(p + 12);
    const float s = (((a[0] + a[1]) + (a[2] + a[3])) + ((b[0] + b[1]) + (b[2] + b[3]))) + (((c[0] + c[1]) + (c[2] + c[3])) + ((d[0] + d[1]) + (d[2] + d[3])));
    return __builtin_amdgcn_rsqf(s * (1.0f / 1024.0f) + cfg::EPS);
}

struct RangeOrder : StaticOrder {
    int pm0; bool g16;
    __device__ __forceinline__ void init(int pm0_, int nMt, int N, int G_, int c_, bool g16_ = false) { StaticOrder::init(nMt * BM, N, G_, c_); pm0 = pm0_; g16 = g16_; }
    __device__ __forceinline__ bool next(int i, Unit& u) const {
        if (g16) { if (i * 16 + c >= nwg) return false; if (nN == 4) { u.pm = pm0 + 4 * i + (c & 3); u.pn = c >> 2; } else if (i < 10) { const int hs = i >= 5 ? 1 : 0, j = i - 5 * hs; u.pm = pm0 + 4 * hs + (c & 3); u.pn = 4 * j + (c >> 2); } else { u.pm = pm0 + (c & 7); u.pn = 20 + (c >> 3); } return true; }
        if (!StaticOrder::next(i, u)) return false; u.pm += pm0; return true; }
};

struct EpiIn {
    static constexpr bool PERM = true, AFTER_DRAIN = false, DRAINS = true; static constexpr int MID_T = 0;
    const float* rstd; bf16_t *U, *Q, *Kb, *Vb, *GT; float* out;
    __device__ __forceinline__ void operator()(const f32x4 (&acc)[2][2][4][2], const Unit& u, int wr, int wc, int fr, int fq) const {
        using namespace cfg;
        const int pn = u.pn, rbase = u.pm * BM + wr * 64 + fr, cl = wc * 32 + 8 * fq, tb = u.pm & 31;
        const bool smp = (u.pm == MP / BM);
        if (pn < 4) {
            const bool hasout = smp || tb == 31;
#pragma unroll
            for (int ai = 0; ai < 2; ++ai)
#pragma unroll
                for (int m = 0; m < 4; ++m) {
                    const int row = rbase + ai * HALF + m * 16; const float rs = rstd[row];
                    f32x4 a0 = acc[ai][0][m][0] * rs, a1 = acc[ai][0][m][1] * rs; const f32x4 b0 = acc[ai][1][m][0] * rs, b1 = acc[ai][1][m][1] * rs;
#pragma unroll
                    for (int e = 0; e < 4; ++e) { a0[e] *= sigm(b0[e]); a1[e] *= sigm(b1[e]); }
                    *(u32x4*)(U + (size_t)row * 512 + pn * 128 + cl) = pack8(a0, a1);
                    if (hasout) {
                        float* dst = nullptr;
                        if (!smp) { const int t = row & 8191; if (t >= 8162) dst = out + O_CONVP + (size_t)((row >> 13) * 30 + (t - 8162)) * 512; }
                        else if (row < MR) { const int si = row - MP; dst = out + O_CONVS + (size_t)((si >> 2) * 30 + 26 + (si & 3)) * 512; }
                        if (dst) { *(f32x4*)(dst + pn * 128 + cl) = a0; *(f32x4*)(dst + pn * 128 + cl + 4) = a1; }
                    }
                }
        } else if (pn < 7) {
            const int g = pn - 4;
#pragma unroll
            for (int ai = 0; ai < 2; ++ai)
#pragma unroll
                for (int m = 0; m < 4; ++m) {
                    const int row = rbase + ai * HALF + m * 16; const float rs = rstd[row] * C2;
#pragma unroll
                    for (int bj = 0; bj < 2; ++bj) *(u32x4*)(Q + (size_t)row * 768 + g * 256 + bj * HALF + cl) = pack8(acc[ai][bj][m][0] * rs, acc[ai][bj][m][1] * rs);
                }
        } else if (pn < 13) {
            const bool isV = pn >= 10; const int g = isV ? pn - 10 : pn - 7, sh = 2 * g, W = 128 << sh;
            bf16_t* base = isV ? Vb : Kb;
            const size_t offp = (g == 0 ? O_KV0P : g == 1 ? O_KV1P : O_KV2P) + (isV ? 256 : 0), offs = (g == 0 ? O_KV0S : g == 1 ? O_KV1S : O_KV2S) + (isV ? 256 : 0);
            const bool hasout = smp || (tb * 256 + 256 > 8192 - W);
#pragma unroll
            for (int ai = 0; ai < 2; ++ai)
#pragma unroll
                for (int m = 0; m < 4; ++m) {
                    const int row = rbase + ai * HALF + m * 16; const float rs = rstd[row];
                    int prow = row; float* dst = nullptr;
                    if (!smp) { const int t = row & 8191; prow = (row & ~8191) + ((t & ((1 << sh) - 1)) << (13 - sh)) + (t >> sh);
                        if (hasout && t >= 8192 - W) dst = out + offp + (size_t)((row >> 13) * W + (t - (8192 - W))) * 512; }
                    else if (row < MR) { const int si = row - MP; dst = out + offs + (size_t)((si >> 2) * W + (W - 4) + (si & 3)) * 512; }
#pragma unroll
                    for (int bj = 0; bj < 2; ++bj) { const f32x4 v0 = acc[ai][bj][m][0] * rs, v1 = acc[ai][bj][m][1] * rs;
                        *(u32x4*)(base + (size_t)prow * 768 + g * 256 + bj * HALF + cl) = pack8(v0, v1);
                        if (dst) { *(f32x4*)(dst + bj * HALF + cl) = v0; *(f32x4*)(dst + bj * HALF + cl + 4) = v1; } }
                }
        } else {
            const int j = pn - 13;
#pragma unroll
            for (int ai = 0; ai < 2; ++ai)
#pragma unroll
                for (int m = 0; m < 4; ++m) {
                    const int row = rbase + ai * HALF + m * 16; const float rs = rstd[row];
                    f32x4 c0 = acc[ai][0][m][0] * rs, c1 = acc[ai][0][m][1] * rs, a0 = acc[ai][1][m][0] * rs, a1 = acc[ai][1][m][1] * rs;
#pragma unroll
                    for (int e = 0; e < 4; ++e) {
                        const float e0 = 1.0f + fminf(__builtin_amdgcn_exp2f(-1.4426950408889634f * a0[e]), 0x1p60f), e1 = 1.0f + fminf(__builtin_amdgcn_exp2f(-1.4426950408889634f * a1[e]), 0x1p60f);
                        c0[e] = sigm(c0[e]) * e0; c1[e] = sigm(c1[e]) * e1; a0[e] = __builtin_amdgcn_rcpf(e0); a1[e] = __builtin_amdgcn_rcpf(e1); }
                    *(u32x4*)(GT + (size_t)row * 2048 + 128 * j + cl) = pack8(c0, c1);
                    *(u32x4*)(GT + (size_t)row * 2048 + 1024 + 128 * j + cl) = pack8(a0, a1);
                }
        }
    }
};
__device__ __forceinline__ void rstd_rows(const float* ssq, int rbase, int fq, float (&rs)[8]) {
    const int ai_o = fq >> 1, m_o = (fq & 1) * 2, lane = (int)__builtin_amdgcn_mbcnt_hi(~0u, __builtin_amdgcn_mbcnt_lo(~0u, 0u));
    const float* p0 = ssq + (size_t)(rbase + ai_o * HALF + m_o * 16) * 16;
    f32x4 t[8];
#pragma unroll
    for (int i = 0; i < 4; ++i) { t[i] = *(const f32x4*)(p0 + 4 * i); t[4 + i] = *(const f32x4*)(p0 + 256 + 4 * i); }
    float r[2];
#pragma unroll
    for (int k = 0; k < 2; ++k) { const f32x4 a = t[4 * k], b = t[4 * k + 1], c = t[4 * k + 2], d = t[4 * k + 3];
        const float sum = (((a[0] + a[1]) + (a[2] + a[3])) + ((b[0] + b[1]) + (b[2] + b[3]))) + (((c[0] + c[1]) + (c[2] + c[3])) + ((d[0] + d[1]) + (d[2] + d[3])));
        r[k] = __builtin_amdgcn_rsqf(sum * (1.0f / 1024.0f) + cfg::EPS); }
#pragma unroll
    for (int ai = 0; ai < 2; ++ai)
#pragma unroll
        for (int m = 0; m < 4; ++m) rs[ai * 4 + m] = __shfl((m & 1) ? r[1] : r[0], (lane & 15) + 16 * (ai * 2 + (m >> 1)));
}
struct EpiGate {
    static constexpr bool PERM = true, AFTER_DRAIN = false, DRAINS = false; static constexpr int MID_T = 0;
    const bf16_t* GT; int goff; bf16_t* O;
    __device__ __forceinline__ void operator()(const f32x4 (&acc)[2][2][4][2], const Unit& u, int wr, int wc, int fr, int fq) const {
        const int rbase = u.pm * BM + wr * 64 + fr, cb = u.pn * BM + wc * 32 + 8 * fq;
        u32x4 gv[2][4][2];
        if (GT) {
#pragma unroll
            for (int ai = 0; ai < 2; ++ai)
#pragma unroll
                for (int m = 0; m < 4; ++m)
#pragma unroll
                    for (int bj = 0; bj < 2; ++bj) gv[ai][m][bj] = *(const u32x4*)(GT + (size_t)(rbase + ai * HALF + m * 16) * 2048 + goff + cb + bj * HALF);
        }
#pragma unroll
        for (int ai = 0; ai < 2; ++ai)
#pragma unroll
            for (int m = 0; m < 4; ++m) { const int row = rbase + ai * HALF + m * 16;
#pragma unroll
                for (int bj = 0; bj < 2; ++bj) { const int col = cb + bj * HALF; f32x4 v0 = acc[ai][bj][m][0], v1 = acc[ai][bj][m][1];
                    if (GT) { f32x4 g0, g1; unpack8(gv[ai][m][bj], g0, g1); v0 = v0 * g0; v1 = v1 * g1; }
                    *(u32x4*)(O + (size_t)row * 1024 + col) = pack8(v0, v1); } }
    }
};
#ifndef MIXHOOK_T
#define MIXHOOK_T 8
#endif
struct EpiMix {
    static constexpr bool PERM = true, AFTER_DRAIN = false, DRAINS = true; static constexpr int MID_T = MIXHOOK_T;
    const bf16_t* GT; bf16_t* O;
    __device__ __forceinline__ void mid(f32x4 (&acc)[2][2][4][2], const Unit& u, int wr, int wc, int fr, int fq) const {
        const int rbase = u.pm * BM + wr * 64 + fr, cb = u.pn * BM + wc * 32 + 8 * fq;
#pragma unroll
        for (int ai = 0; ai < 2; ++ai) {
            u32x4 cv[4][2];
#pragma unroll
            for (int m = 0; m < 4; ++m)
#pragma unroll
                for (int bj = 0; bj < 2; ++bj) cv[m][bj] = *(const u32x4*)(GT + (size_t)(rbase + ai * HALF + m * 16) * 2048 + cb + bj * HALF);
#pragma unroll
            for (int m = 0; m < 4; ++m)
#pragma unroll
                for (int bj = 0; bj < 2; ++bj) { f32x4 c0, c1; unpack8(cv[m][bj], c0, c1); acc[ai][bj][m][0] = acc[ai][bj][m][0] * c0; acc[ai][bj][m][1] = acc[ai][bj][m][1] * c1; }
            asm volatile("" ::: "memory");
        }
    }
    __device__ __forceinline__ void operator()(const f32x4 (&acc)[2][2][4][2], const Unit& u, int wr, int wc, int fr, int fq) const {
        const int rbase = u.pm * BM + wr * 64 + fr, cb = u.pn * BM + wc * 32 + 8 * fq;
        u32x4 gv[2][4][2];
#pragma unroll
        for (int ai = 0; ai < 2; ++ai)
#pragma unroll
            for (int m = 0; m < 4; ++m)
#pragma unroll
                for (int bj = 0; bj < 2; ++bj) gv[ai][m][bj] = *(const u32x4*)(GT + (size_t)(rbase + ai * HALF + m * 16) * 2048 + 1024 + cb + bj * HALF);
#pragma unroll
        for (int ai = 0; ai < 2; ++ai)
#pragma unroll
            for (int m = 0; m < 4; ++m) { const int row = rbase + ai * HALF + m * 16;
#pragma unroll
                for (int bj = 0; bj < 2; ++bj) { f32x4 g0, g1; unpack8(gv[ai][m][bj], g0, g1);
                    *(u32x4*)(O + (size_t)row * 1024 + cb + bj * HALF) = pack8(acc[ai][bj][m][0] * g0, acc[ai][bj][m][1] * g1); } }
    }
};
struct EpiResidIn {
    static constexpr bool PERM = true, AFTER_DRAIN = false, DRAINS = true; static constexpr int MID_T = 0;
    const float* xp; const float* xs; bf16_t* XB; float* ssq;
    __device__ __forceinline__ void operator()(const f32x4 (&acc)[2][2][4][2], const Unit& u, int wr, int wc, int fr, int fq) const {
        using namespace cfg;
        const int rbase = u.pm * BM + wr * 64 + fr, cb = u.pn * BM + wc * 32 + 8 * fq;
#pragma unroll
        for (int ai = 0; ai < 2; ++ai) {
            f32x4 xv[4][2][2];
#pragma unroll
            for (int m = 0; m < 4; ++m) { const int row = rbase + ai * HALF + m * 16; const float* src = row < MP ? xp + (size_t)row * 1024 : xs + (size_t)(row - MP) * 1024;
#pragma unroll
                for (int bj = 0; bj < 2; ++bj) { xv[m][bj][0] = (f32x4){0.f, 0.f, 0.f, 0.f}; xv[m][bj][1] = xv[m][bj][0];
                    if (row < MR) { xv[m][bj][0] = *(const f32x4*)(src + cb + bj * HALF); xv[m][bj][1] = *(const f32x4*)(src + cb + bj * HALF + 4); } } }
#pragma unroll
            for (int m = 0; m < 4; ++m) { const int row = rbase + ai * HALF + m * 16; float q = 0.f;
#pragma unroll
                for (int bj = 0; bj < 2; ++bj) { const f32x4 x0 = xv[m][bj][0] + acc[ai][bj][m][0], x1 = xv[m][bj][1] + acc[ai][bj][m][1];
                    *(u32x4*)(XB + (size_t)row * 1024 + cb + bj * HALF) = pack8(x0, x1); q += dot4(x0) + dot4(x1); }
                q += __shfl_xor(q, 16); q += __shfl_xor(q, 32);
                if (fq == 0) ssq[(size_t)row * 16 + u.pn * 4 + wc] = q; }
            asm volatile("" ::: "memory");
        }
    }
};
struct EpiResidB {
    static constexpr bool PERM = true, AFTER_DRAIN = false, DRAINS = true; static constexpr int MID_T = 0;
    bf16_t* XB; float* ssq;
    __device__ __forceinline__ void operator()(const f32x4 (&acc)[2][2][4][2], const Unit& u, int wr, int wc, int fr, int fq) const {
        const int rbase = u.pm * BM + wr * 64 + fr, cb = u.pn * BM + wc * 32 + 8 * fq;
        u32x4 xv[2][4][2];
#pragma unroll
        for (int ai = 0; ai < 2; ++ai)
#pragma unroll
            for (int m = 0; m < 4; ++m)
#pragma unroll
                for (int bj = 0; bj < 2; ++bj) xv[ai][m][bj] = *(const u32x4*)(XB + (size_t)(rbase + ai * HALF + m * 16) * 1024 + cb + bj * HALF);
#pragma unroll
        for (int ai = 0; ai < 2; ++ai)
#pragma unroll
            for (int m = 0; m < 4; ++m) { const int row = rbase + ai * HALF + m * 16; float q = 0.f;
#pragma unroll
                for (int bj = 0; bj < 2; ++bj) { f32x4 x0, x1; unpack8(xv[ai][m][bj], x0, x1); x0 = x0 + acc[ai][bj][m][0]; x1 = x1 + acc[ai][bj][m][1];
                    *(u32x4*)(XB + (size_t)row * 1024 + cb + bj * HALF) = pack8(x0, x1); q += dot4(x0) + dot4(x1); }
                q += __shfl_xor(q, 16); q += __shfl_xor(q, 32);
                if (fq == 0) ssq[(size_t)row * 16 + u.pn * 4 + wc] = q; }
    }
};
struct EpiUp {
    static constexpr bool PERM = true, AFTER_DRAIN = false, DRAINS = true; static constexpr int MID_T = 0;
    const float* ssq; bf16_t* H; const float *c0, *c1, *c2, *st; float* out;
    __device__ __forceinline__ bool cp_addr(unsigned i, const f32x4*& src, f32x4*& dst) const {
        using namespace cfg;
        constexpr unsigned P0 = 124 * 128, T0 = P0 * 32, P1 = 508 * 128, T1 = P1 * 32, P2 = 2044 * 128, T2 = P2 * 32, P3 = 26 * 128, T3 = P3 * 32;
        if (i < T0) { const unsigned bs = i / P0, r = i - bs * P0; src = (const f32x4*)(c0 + ((size_t)bs * 128 + 4) * 512) + r; dst = (f32x4*)(out + O_KV0S + (size_t)bs * 128 * 512) + r; return true; }
        i -= T0;
        if (i < T1) { const unsigned bs = i / P1, r = i - bs * P1; src = (const f32x4*)(c1 + ((size_t)bs * 512 + 4) * 512) + r; dst = (f32x4*)(out + O_KV1S + (size_t)bs * 512 * 512) + r; return true; }
        i -= T1;
        if (i < T2) { const unsigned bs = i / P2, r = i - bs * P2; src = (const f32x4*)(c2 + ((size_t)bs * 2048 + 4) * 512) + r; dst = (f32x4*)(out + O_KV2S + (size_t)bs * 2048 * 512) + r; return true; }
        i -= T2;
        if (i < T3) { const unsigned bs = i / P3, r = i - bs * P3; src = (const f32x4*)(st + ((size_t)bs * 30 + 4) * 512) + r; dst = (f32x4*)(out + O_CONVS + (size_t)bs * 30 * 512) + r; return true; }
        return false;
    }
    __device__ __forceinline__ void operator()(const f32x4 (&acc)[2][2][4][2], const Unit& u, int wr, int wc, int fr, int fq) const {
        const int rbase = u.pm * BM + wr * 64 + fr, cl = u.pn * HALF + wc * 32 + 8 * fq;
        const unsigned tid = (unsigned)((wr * 4 + wc) * 64 + fr + 16 * fq), chunk = (unsigned)(u.pm * 22 + u.pn);
        f32x4 cv[8]; f32x4* cd[8]; bool ok[8];
#pragma unroll
        for (int k = 0; k < 8; ++k) { const f32x4* sp_; ok[k] = cp_addr((chunk * 8 + k) * 512 + tid, sp_, cd[k]); if (ok[k]) cv[k] = __builtin_nontemporal_load(sp_); }
        float rsv[8]; rstd_rows(ssq, rbase, fq, rsv);
#pragma unroll
        for (int ai = 0; ai < 2; ++ai)
#pragma unroll
            for (int m = 0; m < 4; ++m) { const int row = rbase + ai * HALF + m * 16; const float rs = rsv[ai * 4 + m];
                f32x4 g0 = acc[ai][0][m][0] * rs, g1 = acc[ai][0][m][1] * rs; const f32x4 u0 = acc[ai][1][m][0] * rs, u1 = acc[ai][1][m][1] * rs;
#pragma unroll
                for (int e = 0; e < 4; ++e) { g0[e] = g0[e] * sigm(g0[e]) * u0[e]; g1[e] = g1[e] * sigm(g1[e]) * u1[e]; }
                *(u32x4*)(H + (size_t)row * cfg::DFF + cl) = pack8(g0, g1); }
#pragma unroll
        for (int k = 0; k < 8; ++k) if (ok[k]) __builtin_nontemporal_store(cv[k], cd[k]);
    }
};
struct EpiNull {
    static constexpr bool PERM = true, AFTER_DRAIN = false, DRAINS = false; static constexpr int MID_T = 0;
    __device__ __forceinline__ void operator()(const f32x4 (&acc)[2][2][4][2], const Unit& u, int wr, int wc, int fr, int fq) const {
#pragma unroll
        for (int ai = 0; ai < 2; ++ai)
#pragma unroll
            for (int bj = 0; bj < 2; ++bj)
#pragma unroll
                for (int m = 0; m < 4; ++m) { asm volatile("" :: "v"(acc[ai][bj][m][0]), "v"(acc[ai][bj][m][1])); }
    }
};
struct EpiPleNorm {
    static constexpr bool PERM = true, AFTER_DRAIN = false, DRAINS = true; static constexpr int MID_T = 0;
    const float* ssq2; const bf16_t* PP; const bf16_t* XB; float* out; float* ssq3; unsigned* pcnt; const float* gfin; unsigned* tmo; PG8_LAS float* part;
    __device__ __forceinline__ void operator()(const f32x4 (&acc_)[2][2][4][2], const Unit& u, int wr, int wc, int fr, int fq) const {
        using namespace cfg;
        f32x4 (&acc)[2][2][4][2] = const_cast<f32x4 (&)[2][2][4][2]>(acc_);
        const int rbase = u.pm * BM + wr * 64 + fr, cb = u.pn * BM + wc * 32 + 8 * fq, lane = fr + 16 * fq, tid = (wr * 4 + wc) * 64 + lane;
        float rsv[8]; rstd_rows(ssq2, rbase, fq, rsv);
#pragma unroll
        for (int ai = 0; ai < 2; ++ai) {
            u32x4 pv[4][2], xv[4][2];
#pragma unroll
            for (int m = 0; m < 4; ++m)
#pragma unroll
                for (int bj = 0; bj < 2; ++bj) { const size_t ro = (size_t)(rbase + ai * HALF + m * 16) * 1024 + cb + bj * HALF; pv[m][bj] = *(const u32x4*)(PP + ro); xv[m][bj] = *(const u32x4*)(XB + ro); }
#pragma unroll
            for (int m = 0; m < 4; ++m) { const int rl = wr * 64 + fr + ai * HALF + m * 16; const float rs = rsv[ai * 4 + m]; float q = 0.f;
#pragma unroll
                for (int bj = 0; bj < 2; ++bj) { f32x4 x0, x1, p0, p1; unpack8(pv[m][bj], p0, p1); unpack8(xv[m][bj], x0, x1);
                    const f32x4 s0 = acc[ai][bj][m][0] * rs, s1 = acc[ai][bj][m][1] * rs;
#pragma unroll
                    for (int e = 0; e < 4; ++e) { x0[e] += sigm(s0[e]) * p0[e]; x1[e] += sigm(s1[e]) * p1[e]; }
                    acc[ai][bj][m][0] = x0; acc[ai][bj][m][1] = x1; q += dot4(x0) + dot4(x1); }
                q += __shfl_xor(q, 16); q += __shfl_xor(q, 32);
                if (fq == 0) part[rl * 4 + wc] = q; }
            asm volatile("" ::: "memory");
        }
        asm volatile("s_waitcnt lgkmcnt(0)" ::: "memory"); __builtin_amdgcn_s_barrier(); asm volatile("" ::: "memory");
        if (tid < 256) { const f32x4 p4 = *(const PG8_LAS f32x4*)(part + tid * 4);
            __hip_atomic_store(ssq3 + (size_t)(u.pm * BM + tid) * 4 + u.pn, (p4[0] + p4[1]) + (p4[2] + p4[3]), __ATOMIC_RELAXED, __HIP_MEMORY_SCOPE_AGENT); }
        asm volatile("s_waitcnt vmcnt(0)" ::: "memory"); __builtin_amdgcn_s_barrier(); asm volatile("" ::: "memory");
        unsigned* cw = pcnt + 64 * u.pm;
        if (tid == 0) __hip_atomic_fetch_add(cw, 1u, __ATOMIC_RELAXED, __HIP_MEMORY_SCOPE_AGENT);
        { unsigned sp = 0;
            while ((unsigned)__builtin_amdgcn_readfirstlane(__hip_atomic_load(cw, __ATOMIC_RELAXED, __HIP_MEMORY_SCOPE_AGENT)) < 4u) {
                __builtin_amdgcn_s_sleep(2);
                if (++sp > (1u << 20)) { if (lane == 0) __hip_atomic_store(tmo, 1u, __ATOMIC_RELAXED, __HIP_MEMORY_SCOPE_AGENT); break; } }
            __builtin_amdgcn_fence(__ATOMIC_ACQUIRE, "agent"); }
        float r3[8];
        { const int ai_o = fq >> 1, m_o = (fq & 1) * 2; const float* p0 = ssq3 + (size_t)(rbase + ai_o * HALF + m_o * 16) * 4;
          const f32x4 a = *(const f32x4*)p0, b = *(const f32x4*)(p0 + 64);
          const float ra = __builtin_amdgcn_rsqf(((a[0] + a[1]) + (a[2] + a[3])) * (1.0f / 1024.0f) + EPS), rb = __builtin_amdgcn_rsqf(((b[0] + b[1]) + (b[2] + b[3])) * (1.0f / 1024.0f) + EPS);
#pragma unroll
          for (int ai = 0; ai < 2; ++ai)
#pragma unroll
              for (int m = 0; m < 4; ++m) r3[ai * 4 + m] = __shfl((m & 1) ? rb : ra, fr + 16 * (ai * 2 + (m >> 1))); }
        f32x4 gv[2][2];
#pragma unroll
        for (int bj = 0; bj < 2; ++bj) { gv[bj][0] = *(const f32x4*)(gfin + cb + bj * HALF); gv[bj][1] = *(const f32x4*)(gfin + cb + bj * HALF + 4); }
#pragma unroll
        for (int ai = 0; ai < 2; ++ai)
#pragma unroll
            for (int m = 0; m < 4; ++m) { const int row = rbase + ai * HALF + m * 16; const float rs = r3[ai * 4 + m]; float* dst = out + (size_t)row * 1024;
                if (row < MR) {
#pragma unroll
                    for (int bj = 0; bj < 2; ++bj) { *(f32x4*)(dst + cb + bj * HALF) = acc[ai][bj][m][0] * rs * gv[bj][0]; *(f32x4*)(dst + cb + bj * HALF + 4) = acc[ai][bj][m][1] * rs * gv[bj][1]; } } }
    }
};

template <class Epi, class Sched, bool ALIGN_EPI = false, bool SP2 = false>
__device__ __forceinline__ void gemm_phase(PG8_LAS unsigned char* lds, const Gemm g, const Sched& S, const Epi& E, const int wave_id  ) {
    unsigned z_ = 0u; asm volatile("" : "+s"(z_)); int tid_ = wave_id * 64 + (int)__builtin_amdgcn_mbcnt_hi(~0u, __builtin_amdgcn_mbcnt_lo(~0u, z_)); asm volatile("" : "+v"(tid_));
    const int tid = tid_, wid = __builtin_amdgcn_readfirstlane(tid >> 6), lane = tid & 63, wr = wid >> 2, wc = wid & 3, fr = lane & 15, fq = lane >> 4;
    const int K = g.K, nt = K / BK, LD = g.ld;
    unsigned voffA[2], voffB[2];
#pragma unroll
    for (int i = 0; i < 2; ++i) { int R, C; stage_rc(tid * 16 + i * 8192, R, C); const int Rb = Epi::PERM ? ((R & ~31) + perm32(R & 31)) : R;
        voffA[i] = (unsigned)(R * LD + C) * 2u; voffB[i] = (unsigned)(Rb * LD + C) * 2u; }
    const size_t kstep = (size_t)(BK * 2);
    const size_t hstep = (size_t)HALF * LD * 2;
    const size_t tstep = 2 * hstep;
    const unsigned ldsw = (unsigned)wid * 1024u;
    const int aoff = lds_byte(wr * 64 + fr, fq * 8), boff = lds_byte(wc * 32 + fr, fq * 8);
#define PG8_SA(b, h) (((b) * 2 + (h)) * HTB)
#define PG8_SB(b, h) ((4 + (b) * 2 + (h)) * HTB)
#define PG8_STAGE(bufoff, gbase, voff) do { _Pragma("unroll") for (int _i = 0; _i < 2; ++_i) \
        __builtin_amdgcn_global_load_lds((const unsigned*)((const char*)(gbase) + (voff)[_i]), (PG8_LAS unsigned*)(lds + (bufoff) + ldsw + _i * 8192), 16, 0, 0); } while (0)
#define PG8_LDA(dst, b, h) do { _Pragma("unroll") for (int m = 0; m < 4; ++m) _Pragma("unroll") for (int k = 0; k < 2; ++k) dst[m][k] = *(const PG8_LAS bf16x8*)(lds + PG8_SA(b, h) + aoff + m * 2048 + k * 1024); } while (0)
#define PG8_LDB(dst, b, h) do { _Pragma("unroll") for (int n = 0; n < 2; ++n) _Pragma("unroll") for (int k = 0; k < 2; ++k) dst[n][k] = *(const PG8_LAS bf16x8*)(lds + PG8_SB(b, h) + boff + n * 2048 + k * 1024); } while (0)
#define PG8_MMA(ai, bj, At, Bt) do { __builtin_amdgcn_s_setprio(1); _Pragma("unroll") for (int m = 0; m < 4; ++m) _Pragma("unroll") for (int n = 0; n < 2; ++n) _Pragma("unroll") for (int k = 0; k < 2; ++k) \
        acc[ai][bj][m][n] = __builtin_amdgcn_mfma_f32_16x16x32_bf16(Bt[n][k], At[m][k], acc[ai][bj][m][n], 0, 0, 0); __builtin_amdgcn_s_setprio(0); } while (0)
#define PG8_WAIT_V(n) asm volatile("s_waitcnt vmcnt(" #n ")" ::: "memory")
#define PG8_WAIT_L(n) asm volatile("s_waitcnt lgkmcnt(" #n ")" ::: "memory")
#define PG8_BAR __builtin_amdgcn_s_barrier()
#define PG8_SCHED __builtin_amdgcn_sched_barrier(0)
    Unit cur, nxt; int ui = 0;
    if (!S.next(0, cur)) return;
    f32x4 acc[2][2][4][2];
#pragma unroll
    for (int a = 0; a < 2; ++a)
#pragma unroll
        for (int b = 0; b < 2; ++b)
#pragma unroll
            for (int m = 0; m < 4; ++m)
#pragma unroll
                for (int n = 0; n < 2; ++n) acc[a][b][m][n] = (f32x4){0.f, 0.f, 0.f, 0.f};
    bf16x8 At[4][2], B0[2][2], B1[2][2];
    const char* cA = (const char*)g.A + (size_t)cur.pm * tstep; const char* cB = (const char*)g.Bt + (size_t)cur.pn * tstep;
    S.a_ready(cur);
    if constexpr (SP2) {
        PG8_STAGE(PG8_SB(0, 0), cB, voffB); PG8_STAGE(PG8_SB(0, 1), cB + hstep, voffB); PG8_STAGE(PG8_SA(0, 0), cA, voffA); PG8_STAGE(PG8_SA(0, 1), cA + hstep, voffA);
        if (wr == 1) PG8_BAR;
        PG8_WAIT_V(2); PG8_BAR;
        PG8_STAGE(PG8_SB(1, 0), cB + kstep, voffB); PG8_STAGE(PG8_SA(1, 0), cA + kstep, voffA); PG8_STAGE(PG8_SB(1, 1), cB + hstep + kstep, voffB);
        PG8_WAIT_V(6); PG8_BAR;
    } else {
        PG8_STAGE(PG8_SB(0, 0), cB, voffB); PG8_STAGE(PG8_SA(0, 0), cA, voffA); PG8_STAGE(PG8_SB(0, 1), cB + hstep, voffB); PG8_STAGE(PG8_SA(0, 1), cA + hstep, voffA);
        if (wr == 1) PG8_BAR;
        PG8_WAIT_V(4); PG8_BAR;
        PG8_STAGE(PG8_SB(1, 0), cB + kstep, voffB); PG8_STAGE(PG8_SA(1, 0), cA + kstep, voffA); PG8_STAGE(PG8_SB(1, 1), cB + hstep + kstep, voffB);
        PG8_WAIT_V(6); PG8_BAR;
    }
    for (;;) {
        const bool has_next = S.next(ui + 1, nxt);
        const char* nA = has_next ? (const char*)g.A + (size_t)nxt.pm * tstep : cA; const char* nB = has_next ? (const char*)g.Bt + (size_t)nxt.pn * tstep : cB;
        for (int t = 0; t < nt; t += 2) {
            if constexpr (Epi::MID_T > 0) { if (t == Epi::MID_T) {
                unsigned z3_ = 0u; asm volatile("" : "+s"(z3_)); int l3_ = (int)__builtin_amdgcn_mbcnt_hi(~0u, __builtin_amdgcn_mbcnt_lo(~0u, z3_)); asm volatile("" : "+v"(l3_));
                E.mid(acc, cur, wr, wc, l3_ & 15, l3_ >> 4); } }
            const bool last = (t == nt - 2);
            const char* a1 = cA + (size_t)(t + 1) * kstep;
            const char* a2 = last ? nA : cA + (size_t)(t + 2) * kstep; const char* b2 = last ? nB : cB + (size_t)(t + 2) * kstep;
            const char* a3 = a2 + kstep; const char* b3 = b2 + kstep;
            if (last && has_next) S.a_ready(nxt);
            if constexpr (SP2) {
            PG8_LDB(B0, 0, 0); PG8_LDB(B1, 0, 1); PG8_SCHED; PG8_LDA(At, 0, 0); PG8_STAGE(PG8_SA(1, 1), a1 + hstep, voffA);
            PG8_WAIT_V(8); PG8_WAIT_L(0); PG8_BAR; PG8_MMA(0, 0, At, B0); PG8_MMA(0, 1, At, B1); PG8_BAR; PG8_SCHED;
            PG8_LDA(At, 0, 1); PG8_STAGE(PG8_SB(0, 0), b2, voffB); PG8_STAGE(PG8_SB(0, 1), b2 + hstep, voffB); PG8_STAGE(PG8_SA(0, 0), a2, voffA);
            PG8_WAIT_V(8); PG8_WAIT_L(0); PG8_BAR; PG8_MMA(1, 0, At, B0); PG8_MMA(1, 1, At, B1); PG8_BAR; PG8_SCHED;
            PG8_LDB(B0, 1, 0); PG8_LDB(B1, 1, 1); PG8_SCHED; PG8_LDA(At, 1, 0); PG8_STAGE(PG8_SA(0, 1), a2 + hstep, voffA);
            PG8_WAIT_V(8); PG8_WAIT_L(0); PG8_BAR; PG8_MMA(0, 0, At, B0); PG8_MMA(0, 1, At, B1); PG8_BAR; PG8_SCHED;
            PG8_LDA(At, 1, 1); PG8_STAGE(PG8_SB(1, 0), b3, voffB); PG8_STAGE(PG8_SB(1, 1), b3 + hstep, voffB); PG8_STAGE(PG8_SA(1, 0), a3, voffA);
            PG8_WAIT_V(8); PG8_WAIT_L(0); PG8_BAR; PG8_MMA(1, 0, At, B0); PG8_MMA(1, 1, At, B1); PG8_BAR; PG8_SCHED;
            } else {
            PG8_LDB(B0, 0, 0); PG8_SCHED; PG8_LDA(At, 0, 0); PG8_STAGE(PG8_SA(1, 1), a1 + hstep, voffA);
            PG8_WAIT_L(8); PG8_BAR; PG8_WAIT_L(0); PG8_MMA(0, 0, At, B0); PG8_BAR; PG8_SCHED;
            PG8_LDB(B1, 0, 1); PG8_STAGE(PG8_SB(0, 0), b2, voffB);
            PG8_BAR; PG8_WAIT_L(0); PG8_MMA(0, 1, At, B1); PG8_BAR;
            PG8_LDA(At, 0, 1); PG8_STAGE(PG8_SA(0, 0), a2, voffA);
            PG8_BAR; PG8_WAIT_L(0); PG8_MMA(1, 0, At, B0); PG8_BAR; PG8_SCHED;
            PG8_STAGE(PG8_SB(0, 1), b2 + hstep, voffB);
            PG8_WAIT_V(6); PG8_BAR; PG8_MMA(1, 1, At, B1); PG8_BAR;
            PG8_LDB(B0, 1, 0); PG8_SCHED; PG8_LDA(At, 1, 0); PG8_STAGE(PG8_SA(0, 1), a2 + hstep, voffA);
            PG8_WAIT_L(8); PG8_BAR; PG8_WAIT_L(0); PG8_MMA(0, 0, At, B0); PG8_BAR; PG8_SCHED;
            PG8_LDB(B1, 1, 1); PG8_STAGE(PG8_SB(1, 0), b3, voffB);
            PG8_BAR; PG8_WAIT_L(0); PG8_MMA(0, 1, At, B1); PG8_BAR;
            PG8_LDA(At, 1, 1); PG8_STAGE(PG8_SA(1, 0), a3, voffA);
            PG8_BAR; PG8_WAIT_L(0); PG8_MMA(1, 0, At, B0); PG8_BAR; PG8_SCHED;
            PG8_STAGE(PG8_SB(1, 1), b3 + hstep, voffB);
            PG8_WAIT_V(6); PG8_BAR; PG8_MMA(1, 1, At, B1); PG8_BAR;
            }
        }
        if constexpr (ALIGN_EPI) { if (wr == 0) PG8_BAR; }
        if constexpr (!Epi::AFTER_DRAIN) {
            unsigned z2_ = 0u; asm volatile("" : "+s"(z2_)); int l2_ = (int)__builtin_amdgcn_mbcnt_hi(~0u, __builtin_amdgcn_mbcnt_lo(~0u, z2_)); asm volatile("" : "+v"(l2_));
            E(acc, cur, wr, wc, l2_ & 15, l2_ >> 4); S.done(cur); }
        if (!has_next) break;
#pragma unroll
        for (int a = 0; a < 2; ++a)
#pragma unroll
            for (int b = 0; b < 2; ++b)
#pragma unroll
                for (int m = 0; m < 4; ++m)
#pragma unroll
                    for (int n = 0; n < 2; ++n) acc[a][b][m][n] = (f32x4){0.f, 0.f, 0.f, 0.f};
        cur = nxt; cA = nA; cB = nB; ++ui;
        if constexpr (ALIGN_EPI) { if (wr == 1) PG8_BAR; }
    }
    PG8_WAIT_V(0);
    if constexpr (!ALIGN_EPI) { if (wr == 0) PG8_BAR; }
    PG8_BAR;
    if constexpr (Epi::AFTER_DRAIN) { E.fused(acc, cur, wr, wc, fr, fq, lds, wid, lane); S.done(cur); }
#undef PG8_SA
#undef PG8_SB
#undef PG8_STAGE
#undef PG8_LDA
#undef PG8_LDB
#undef PG8_MMA
#undef PG8_WAIT_V
#undef PG8_WAIT_L
#undef PG8_BAR
#undef PG8_SCHED
}
}
#define GAS __attribute__((address_space(1)))
#define LAS __attribute__((address_space(3)))
typedef unsigned short bf16;
typedef unsigned v4u __attribute__((ext_vector_type(4)));
typedef float f32x4 __attribute__((ext_vector_type(4)));
typedef short bf16x8 __attribute__((ext_vector_type(8)));
typedef GAS unsigned gu32;
typedef GAS unsigned long long gu64;
#define RLX_AGENT __ATOMIC_RELAXED, __HIP_MEMORY_SCOPE_AGENT
#define LDS_WAIT() asm volatile("s_waitcnt lgkmcnt(0)" ::: "memory")
#define VM_WAIT() asm volatile("s_waitcnt vmcnt(0)" ::: "memory")
__device__ __forceinline__ unsigned long long rt() { return __builtin_amdgcn_s_memrealtime(); }
__device__ __forceinline__ unsigned f2bf(float f) { unsigned u = __builtin_bit_cast(unsigned, f); return (u + 0x7fffu + ((u >> 16) & 1u)) >> 16; }
__device__ __forceinline__ unsigned pk2(float lo, float hi) { return f2bf(lo) | (f2bf(hi) << 16); }
#define XB_TMO      128
#define XB_XCNT(j)  (256  + 64 * (j))
#define XB_XSUB(j)  (1280 + 64 * (j))
#define XB_XGEN(j)  (2304 + 64 * (j))
#define XB_TOP      3328
#define XB_TOPGEN   3392
#define XCD_BAR_WORDS 3456
#define XB_SPIN_CAP (1u << 18)

__device__ __forceinline__ unsigned xb_ld(unsigned* p)              { return __hip_atomic_load(p, __ATOMIC_RELAXED, __HIP_MEMORY_SCOPE_AGENT); }
__device__ __forceinline__ unsigned xb_add(unsigned* p, unsigned v) { return __hip_atomic_fetch_add(p, v, __ATOMIC_RELAXED, __HIP_MEMORY_SCOPE_AGENT); }
__device__ __forceinline__ unsigned xb_xcc_id() { return (unsigned)__builtin_amdgcn_s_getreg((3 << 11) | 20) & 0xFu; }
#define XB_SPIN(cond, bar) do { unsigned _sp = 0; while (cond) { __builtin_amdgcn_s_sleep(1); \
    if ((++_sp & 255u) == 0u) { if (xb_ld(&(bar)[XB_TMO])) break; if (_sp > XB_SPIN_CAP) { atomicAdd(&(bar)[XB_TMO], 1u); break; } } } } while (0)

struct XcdBarrier {
    unsigned* bar; unsigned x; unsigned gsize;
    volatile LAS unsigned* st;
};

__device__ __forceinline__ XcdBarrier xcd_barrier_post(unsigned* bar, volatile LAS unsigned* st) {
    XcdBarrier b; b.bar = bar; b.x = xb_xcc_id(); b.st = st; b.gsize = 0u;
    if (threadIdx.x == 0) (void)xb_add(&bar[XB_XCNT(b.x)], 1u);
    return b;
}
__device__ __forceinline__ void xcd_barrier_complete(unsigned* bar, unsigned x, unsigned& nloc, unsigned& nx, unsigned gsize = 0u) {
    const unsigned G = gsize ? gsize : gridDim.x * gridDim.y * gridDim.z;
    unsigned sum, cnt, mine, sp = 0u;
    for (;;) {
        sum = 0u; cnt = 0u; mine = 0u;
#pragma unroll
        for (unsigned j = 0; j < 16; ++j) { const unsigned c = xb_ld(&bar[XB_XCNT(j)]); sum += c; cnt += (c > 0u) ? 1u : 0u; mine = (j == x) ? c : mine; }
        if (sum == G) break;
        __builtin_amdgcn_s_sleep(1);
        if ((++sp & 255u) == 0u) { if (xb_ld(&bar[XB_TMO])) break; if (sp > XB_SPIN_CAP) { atomicAdd(&bar[XB_TMO], 1u); break; } }
    }
    nloc = mine > 0u ? mine : 1u; nx = cnt > 0u ? cnt : 1u;
}

__device__ __forceinline__ void xcd_barrier(const XcdBarrier& b) {
    asm volatile("s_waitcnt vmcnt(0)" ::: "memory");
    __syncthreads();
    if (threadIdx.x == 0) {
        unsigned* bar = b.bar;
        __builtin_amdgcn_s_waitcnt(0);
        unsigned nloc = b.st[0], nx = b.st[1];
        if (nloc == 0u) { xcd_barrier_complete(bar, b.x, nloc, nx, b.gsize); b.st[0] = nloc; b.st[1] = nx; }
        const unsigned old = xb_add(&bar[XB_XSUB(b.x)], 1u);
        const unsigned gen = old / nloc;
        if (old + 1u == (gen + 1u) * nloc) {
            __builtin_amdgcn_fence(__ATOMIC_RELEASE, "agent");
            asm volatile("s_waitcnt vmcnt(0)" ::: "memory");
            const unsigned og = xb_add(&bar[XB_TOP], 1u);
            const unsigned tg = og / nx;
            if (og + 1u == (tg + 1u) * nx) xb_add(&bar[XB_TOPGEN], 1u);
            else XB_SPIN(xb_ld(&bar[XB_TOPGEN]) == tg, bar);
            __builtin_amdgcn_fence(__ATOMIC_ACQUIRE, "agent");
            xb_add(&bar[XB_XGEN(b.x)], 1u);
            asm volatile("s_waitcnt vmcnt(0)" ::: "memory");
        } else {
            XB_SPIN(xb_ld(&bar[XB_XGEN(b.x)]) == gen, bar);
            __builtin_amdgcn_fence(__ATOMIC_ACQUIRE, "agent");
            asm volatile("s_waitcnt vmcnt(0)" ::: "memory");
        }
    }
    __syncthreads();
}


using namespace cfg;
constexpr int NWAVES = 8, NTHREADS = 512;
#ifndef MK_N_LAUNCHES
#define MK_N_LAUNCHES 1
#endif
constexpr int NPHASE = 9;
constexpr int N_LAUNCHES = MK_N_LAUNCHES;

constexpr size_t MiB = 1u << 20;
constexpr size_t WS_CTL = 0, CTL_ZERO_BYTES = 400 * 1024;
constexpr size_t WS_RSTD0 = 1 * MiB, WS_SSQ1 = 2 * MiB, WS_SSQ2 = 5 * MiB, WS_SSQ3 = 8 * MiB;
constexpr size_t WS_W_IN = 12 * MiB, WS_W_C = 23 * MiB, WS_W_A = 24 * MiB, WS_W_O = 25 * MiB, WS_W_UP = 27 * MiB, WS_W_DN = 38 * MiB, WS_W_PG = 44 * MiB, WS_W_PL = 46 * MiB;
constexpr size_t WS_PB = 48 * MiB;
constexpr size_t WS_XB = 66 * MiB;
constexpr size_t WS_CO = WS_XB;
constexpr size_t WS_R1 = 132 * MiB;
constexpr size_t WS_U = WS_R1, WS_Q = WS_R1 + 33 * MiB, WS_K = WS_R1 + 82 * MiB, WS_V = WS_R1 + 131 * MiB;
constexpr size_t WS_MIX = WS_R1, WS_H = WS_R1;
constexpr size_t WS_GT = 312 * MiB;
constexpr size_t WS_PP = 441 * MiB;
constexpr size_t WS_SMP = 506 * MiB;
constexpr size_t WS_SMP_CO = WS_SMP, WS_SMP_MIX = WS_SMP + 512 * 1024, WS_SMP_H = WS_SMP + 2 * MiB;
constexpr size_t WS_END = 510 * MiB;
static_assert(WS_PP + (size_t)MPAD * 1024 * 2 <= WS_SMP && WS_END <= 512 * MiB, "ws map 0");
static_assert(WS_V + (size_t)MPAD * 768 * 2 <= WS_GT && WS_H + (size_t)MPAD * DFF * 2 <= WS_GT && WS_GT + (size_t)MPAD * 2048 * 2 <= WS_END, "ws map");
static_assert(WS_CO + (size_t)MPAD * 768 * 2 <= WS_R1 && WS_PB + (size_t)MPAD * 256 * 2 <= WS_XB, "ws map 2");
static_assert(WS_W_IN + (size_t)NIN * 1024 * 2 <= WS_W_C && WS_W_UP + (size_t)2 * DFF * 1024 * 2 <= WS_W_DN && WS_W_DN + (size_t)DFF * 1024 * 2 <= WS_W_PG && WS_SSQ1 + (size_t)MPAD * 64 <= WS_SSQ2, "ws map 3");
constexpr int CW_BAR = 1024, CW_PBAR = 31744, CW_SBAR = 35200, CW_PFLAG = 38784, CW_GBAR = 40960;

constexpr int RING_BYTES = 131072, LDSCTL_OFF = RING_BYTES, MISC_OFF = LDSCTL_OFF + 320, LDS_BYTES = 147456;

struct Args { const float* in[25]; float* out; unsigned char* ws; int ph_lo, ph_hi; };

#define DPPF(v, ctrl) __builtin_bit_cast(float, __builtin_amdgcn_update_dpp(0, __builtin_bit_cast(int, (v)), (ctrl), 0xf, 0xf, false))
#define RDLF(v, l) __builtin_bit_cast(float, __builtin_amdgcn_readlane(__builtin_bit_cast(int, (v)), (l)))
__device__ __forceinline__ float wave_sum(float v) {
    v += DPPF(v, 0xB1); v += DPPF(v, 0x4E); v += DPPF(v, 0x141); v += DPPF(v, 0x140);
    return (RDLF(v, 0) + RDLF(v, 16)) + (RDLF(v, 32) + RDLF(v, 48));
}
__device__ __forceinline__ float wave_max(float v) {
    v = fmaxf(v, DPPF(v, 0xB1)); v = fmaxf(v, DPPF(v, 0x4E)); v = fmaxf(v, DPPF(v, 0x141)); v = fmaxf(v, DPPF(v, 0x140));
    return fmaxf(fmaxf(RDLF(v, 0), RDLF(v, 16)), fmaxf(RDLF(v, 32), RDLF(v, 48)));
}
__device__ __forceinline__ float bflo(unsigned w) { return __uint_as_float(w << 16); }
__device__ __forceinline__ float bfhi(unsigned w) { return __uint_as_float(w & 0xffff0000u); }
__device__ __forceinline__ float fsig(float x) { return __builtin_amdgcn_rcpf(1.0f + __builtin_amdgcn_exp2f(-1.4426950408889634f * x)); }

__device__ __forceinline__ void p0_transpose_item(const float* W, int ldw, int k0, int n0, bf16* WT, int ldt, int row0, const float* gk, LAS float* scr, int lane, int kd0 = 0) {
    { f32x4 t4[8];
#pragma unroll
        for (int i = 0; i < 8; ++i) { const int kk = 8 * i + (lane >> 3); t4[i] = __builtin_nontemporal_load((const f32x4*)(W + (size_t)(k0 + kk) * ldw + n0 + 4 * (lane & 7))); }
#pragma unroll
        for (int i = 0; i < 8; ++i) { const int kk = 8 * i + (lane >> 3); const float gs = gk ? gk[k0 + kk] : 1.0f; LAS float* d = scr + kk * 33 + 4 * (lane & 7);
            d[0] = t4[i][0] * gs; d[1] = t4[i][1] * gs; d[2] = t4[i][2] * gs; d[3] = t4[i][3] * gs; } }
    LDS_WAIT(); asm volatile("" ::: "memory");
    const int c = lane & 7;
#pragma unroll
    for (int j = 0; j < 4; ++j) { const int n = (lane >> 3) + 8 * j; const LAS float* s = scr + (8 * c) * 33 + n;
        v4u o; o.x = pk2(s[0 * 33], s[1 * 33]); o.y = pk2(s[2 * 33], s[3 * 33]); o.z = pk2(s[4 * 33], s[5 * 33]); o.w = pk2(s[6 * 33], s[7 * 33]);
        *(GAS v4u*)(WT + (size_t)(row0 + n) * ldt + kd0 + k0 + 8 * c) = o; }
    LDS_WAIT(); asm volatile("" ::: "memory");
}
__device__ __forceinline__ void p0_mat_item(const float* W, int K, int ldw, int csrc0, int ncols, bf16* WT, int ldt, int row0, const float* gk, LAS float* scr, int it, int lane, int kd0 = 0) {
    const int nblk = ncols / 32, kb = it / nblk, nb = it % nblk;
    p0_transpose_item(W, ldw, 64 * kb, csrc0 + 32 * nb, WT, ldt, row0 + 32 * nb, gk, scr, lane, kd0);
}

typedef float f32x16 __attribute__((ext_vector_type(16)));
typedef short v4i16_t __attribute__((ext_vector_type(4)));
__device__ __forceinline__ int crow(int r, int hi) { return (r & 3) + 8 * (r >> 2) + 4 * hi; }
constexpr int VPITCH = 144;
constexpr int ATT_WSF = 32 * VPITCH, ATT_OST = ATT_WSF + 256, ATT_WAVE_BYTES = 9216;
static_assert(ATT_OST + 4096 <= ATT_WAVE_BYTES && ATT_WAVE_BYTES * NWAVES <= RING_BYTES, "attention LDS");

struct AttState { float m, l; f32x16 o0, o1; };

__device__ __forceinline__ void att_tile(const bool MASKED  , AttState& st, const bf16x8 (&kf)[4], const v4u (&vv)[4], const bf16x8 (&qf)[4], int n, int uq, float slope2,
                                         LAS unsigned char* wl, const LAS unsigned char* vtr0, int lane) {
    const int c = lane & 31, h = lane >> 5;
    LAS float* wsf = (LAS float*)(wl + ATT_WSF);
    f32x16 s = {};
#pragma unroll
    for (int k = 0; k < 4; ++k) s = __builtin_amdgcn_mfma_f32_32x32x16_bf16(kf[k], qf[k], s, 0, 0, 0);
#pragma unroll
    for (int i = 0; i < 4; ++i) *(LAS v4u*)(wl + (lane >> 1) * VPITCH + (lane & 1) * 64 + 16 * i) = vv[i];
    asm volatile("" ::: "memory");
    const int dbase = uq - 32 * n - 4 * h;
    const float tc = -slope2 * (float)dbase;
    float mx = -INFINITY;
    if (MASKED) {
#pragma unroll
        for (int r = 0; r < 16; ++r) { const int ko = (r & 3) + 8 * (r >> 2); s[r] = ((unsigned)(dbase - ko) <= 128u) ? s[r] : -INFINITY; }
    }
#pragma unroll
    for (int r = 0; r < 16; ++r) { const int ko = (r & 3) + 8 * (r >> 2); s[r] += slope2 * (float)ko; mx = fmaxf(mx, s[r]); }
    mx += tc; { const auto sw = __builtin_amdgcn_permlane32_swap(__float_as_uint(mx), __float_as_uint(mx), false, false); mx = fmaxf(__uint_as_float(sw[0]), __uint_as_float(sw[1])); }
    if (__any(mx > st.m + 8.0f)) {
        const float mnew = fmaxf(st.m, mx), f = __builtin_amdgcn_exp2f(st.m - mnew);
        st.l *= f; st.m = mnew;
        if (h == 0) wsf[c] = f;
        asm volatile("" ::: "memory");
#pragma unroll
        for (int r = 0; r < 16; ++r) { const float fr_ = wsf[crow(r, h)]; st.o0[r] *= fr_; st.o1[r] *= fr_; }
        asm volatile("" ::: "memory");
    }
    const float off = tc - st.m; float ps = 0.f;
#pragma unroll
    for (int r = 0; r < 16; ++r) { s[r] = __builtin_amdgcn_exp2f(s[r] + off); ps += s[r]; }
    st.l += ps;
    v4u pw0, pw1;
    pw0.x = pg8::cvt_pk_bf16(s[0], s[1]); pw0.y = pg8::cvt_pk_bf16(s[2], s[3]); pw0.z = pg8::cvt_pk_bf16(s[4], s[5]); pw0.w = pg8::cvt_pk_bf16(s[6], s[7]);
    pw1.x = pg8::cvt_pk_bf16(s[8], s[9]); pw1.y = pg8::cvt_pk_bf16(s[10], s[11]); pw1.z = pg8::cvt_pk_bf16(s[12], s[13]); pw1.w = pg8::cvt_pk_bf16(s[14], s[15]);
    const bf16x8 pa0 = __builtin_bit_cast(bf16x8, pw0), pa1 = __builtin_bit_cast(bf16x8, pw1);
#pragma unroll
    for (int nb = 0; nb < 2; ++nb)
#pragma unroll
        for (int ks = 0; ks < 2; ++ks) {
            const LAS unsigned char* p = vtr0 + (16 * ks) * VPITCH + 64 * nb;
            const v4i16_t lo = __builtin_amdgcn_ds_read_tr16_b64_v4i16((LAS v4i16_t*)p);
            const v4i16_t hi = __builtin_amdgcn_ds_read_tr16_b64_v4i16((LAS v4i16_t*)(p + 8 * VPITCH));
            const bf16x8 vf = (bf16x8){lo[0], lo[1], lo[2], lo[3], hi[0], hi[1], hi[2], hi[3]};
            if (nb == 0) st.o0 = __builtin_amdgcn_mfma_f32_32x32x16_bf16(ks == 0 ? pa0 : pa1, vf, st.o0, 0, 0, 0);
            else         st.o1 = __builtin_amdgcn_mfma_f32_32x32x16_bf16(ks == 0 ? pa0 : pa1, vf, st.o1, 0, 0, 0);
        }
    asm volatile("" ::: "memory");
}
constexpr int ATT2_WAVE_BYTES = 4864, ATT2_COMB = 40960, ATT2_LSE = ATT2_COMB + 65536;
static_assert(ATT2_WAVE_BYTES >= ATT_WSF + 256 && ATT2_WAVE_BYTES * NWAVES <= ATT2_COMB && ATT2_LSE + 2048 <= RING_BYTES, "attention LDS (regrouped)");
template <int G, bool FIRST>
__device__ __forceinline__ void att_job2(const bf16* Q, const bf16* Kb, const bf16* Vb, int b, int slot, int sp, int jq, LAS unsigned char* wl, LAS bf16* comb, LAS float* lsea, int lane) {
    constexpr int SH = 2 * G, D = 1 << SH, SG = 8192 >> SH;
    const int c = lane & 31, h = lane >> 5;
    int tl0, ts, rg, u0;
    if (G == 2) { tl0 = jq; ts = 16; rg = jq; u0 = 32 * sp; }
    else if (G == 1) { tl0 = 128 * (jq >> 2) + (jq & 3); ts = 4; rg = jq & 3; u0 = 128 * sp + 32 * (jq >> 2); }
    else { tl0 = 32 * jq; ts = 1; rg = 0; u0 = 512 * sp + 32 * jq; }
    float slope2 = __builtin_amdgcn_exp2f(-8.0f * (float)(4 * G + slot + 1) / 12.0f) * (1.4426950408889634f * (float)D);
    asm volatile("" : "+v"(slope2));
    const int colb = 256 * G + 64 * slot, uq = u0 + c;
    const bf16* qp = Q + ((size_t)b * 8192 + 512 * sp + tl0 + ts * c) * 768 + colb + 8 * h;
    bf16x8 qf[4];
#pragma unroll
    for (int s = 0; s < 4; ++s) qf[s] = *(const bf16x8*)(qp + 16 * s);
    const int n_hi = u0 >> 5; int n_lo = n_hi - 4; if (n_lo < 0) n_lo = 0;
    const size_t kvrow0 = (size_t)b * 8192 + (size_t)rg * SG;
    const LAS unsigned char* vtr0 = wl + (4 * h + ((lane & 15) >> 2)) * VPITCH + (16 * ((lane >> 4) & 1) + 4 * (lane & 3)) * 2;
    const bf16* kbase = Kb + (kvrow0 + c) * 768 + colb + 8 * h;
    const bf16* vbase = Vb + (kvrow0 + (lane >> 1)) * 768 + colb + 32 * (lane & 1);
#define ATT_LOAD(KF, VV, nn) do { const bf16* kp_ = kbase + (size_t)(nn) * (32 * 768); const bf16* vp_ = vbase + (size_t)(nn) * (32 * 768); \
        _Pragma("unroll") for (int s_ = 0; s_ < 4; ++s_) KF[s_] = *(const bf16x8*)(kp_ + 16 * s_); \
        _Pragma("unroll") for (int i_ = 0; i_ < 4; ++i_) VV[i_] = *(const v4u*)(vp_ + 8 * i_); } while (0)
    AttState st; st.m = -1e30f; st.l = 0.f; st.o0 = (f32x16){}; st.o1 = (f32x16){};
    bf16x8 kfA[4], kfB[4]; v4u vvA[4], vvB[4];
    ATT_LOAD(kfA, vvA, n_lo);
    for (int n = n_lo;;) {
        { const int nn = n + 1 < n_hi ? n + 1 : n_hi; ATT_LOAD(kfB, vvB, nn); }
        att_tile(!(n < n_hi && n > n_hi - 4), st, kfA, vvA, qf, n, uq, slope2, wl, vtr0, lane);
        if (n == n_hi) break; ++n;
        { const int nn = n + 1 < n_hi ? n + 1 : n_hi; ATT_LOAD(kfA, vvA, nn); }
        att_tile(!(n < n_hi && n > n_hi - 4), st, kfB, vvB, qf, n, uq, slope2, wl, vtr0, lane);
        if (n == n_hi) break; ++n;
    }
#undef ATT_LOAD
    LAS float* wsf = (LAS float*)(wl + ATT_WSF);
    const float lt = st.l + __shfl_xor(st.l, 32);
    const float lsej = st.m + __builtin_amdgcn_logf(lt);
    const int tlq = tl0 + ts * c;
    if (FIRST) { if (h == 0) { wsf[c] = __builtin_amdgcn_rcpf(lt); lsea[tlq] = lsej; } }
    else if (h == 0) { const float lc = lsea[tlq], M = fmaxf(lc, lsej), wc = __builtin_amdgcn_exp2f(lc - M), wj = __builtin_amdgcn_exp2f(lsej - M), is = __builtin_amdgcn_rcpf(wc + wj);
        wsf[c] = wc * is; wsf[32 + c] = wj * is * __builtin_amdgcn_rcpf(lt); lsea[tlq] = M + __builtin_amdgcn_logf(wc + wj); }
    asm volatile("s_waitcnt lgkmcnt(0)" ::: "memory");
#pragma unroll
    for (int r = 0; r < 16; ++r) { const int q = crow(r, h); LAS bf16* cp = comb + (tl0 + ts * q) * 64 + c;
        if (FIRST) { const float inv = wsf[q]; cp[0] = (bf16)f2bf(st.o0[r] * inv); cp[32] = (bf16)f2bf(st.o1[r] * inv); }
        else { const float wa = wsf[q], wb = wsf[32 + q]; const float c0 = __uint_as_float((unsigned)cp[0] << 16), c1 = __uint_as_float((unsigned)cp[32] << 16);
            cp[0] = (bf16)f2bf(c0 * wa + st.o0[r] * wb); cp[32] = (bf16)f2bf(c1 * wa + st.o1[r] * wb); } }
    asm volatile("s_waitcnt lgkmcnt(0)" ::: "memory");
}
__device__ __forceinline__ void att_unit2(const bf16* Q, const bf16* Kb, const bf16* Vb, bf16* OB, int b, int slot, int sp, LAS unsigned char* lds, int tid) {
    const int lane = tid & 63, wave = __builtin_amdgcn_readfirstlane(tid >> 6);
    LAS unsigned char* wl = lds + wave * ATT2_WAVE_BYTES; LAS bf16* comb = (LAS bf16*)(lds + ATT2_COMB); LAS float* lsea = (LAS float*)(lds + ATT2_LSE);
#pragma unroll 1
    for (int jj = 0; jj < 2; ++jj) att_job2<2, true>(Q, Kb, Vb, b, slot, sp, wave + 8 * jj, wl, comb, lsea, lane);
    __syncthreads();
#pragma unroll 1
    for (int jj = 0; jj < 2; ++jj) att_job2<1, false>(Q, Kb, Vb, b, slot, sp, 4 * (2 * (wave >> 2) + jj) + (wave & 3), wl, comb, lsea, lane);
    __syncthreads();
#pragma unroll 1
    for (int jj = 0; jj < 2; ++jj) att_job2<0, false>(Q, Kb, Vb, b, slot, sp, 2 * wave + jj, wl, comb, lsea, lane);
    __syncthreads();
#pragma unroll
    for (int ps = 0; ps < 8; ++ps) { const int row = ps * 64 + (tid >> 3), ch = tid & 7;
        const v4u v = *(const LAS v4u*)(comb + row * 64 + ch * 8);
        *(v4u*)(OB + ((size_t)b * 8192 + 512 * sp + row) * 768 + 512 + 64 * slot + ch * 8) = v; }
    __syncthreads();
}

constexpr int CONV_ROWS = 94, CONV_CBUF_OFF = 96256;
static_assert(CONV_CBUF_OFF + 32 * 512 * 2 <= RING_BYTES, "conv LDS");
__device__ __forceinline__ void conv_tile(const bf16* U, bf16* CB, const float* w_dw, const float* b_dw, const float* ln_g, const float* ln_b, int b, int t0, LAS unsigned char* lds, int tid) {
    const int lane = tid & 63, wave = tid >> 6;
    LAS bf16* us = (LAS bf16*)lds;
    { v4u stg[12];
#pragma unroll
        for (int k = 0; k < 12; ++k) { const int j = wave + NWAVES * k, t = t0 - 30 + j; stg[k] = (v4u){0u, 0u, 0u, 0u};
            if (j < CONV_ROWS && t >= 0) stg[k] = *(const v4u*)(U + ((size_t)b * 8192 + t) * 512 + lane * 8); }
#pragma unroll
        for (int k = 0; k < 12; ++k) { const int j = wave + NWAVES * k; if (j < CONV_ROWS) *(LAS v4u*)(us + j * 512 + lane * 8) = stg[k]; } }
    __syncthreads();
    const int cp = tid & 255, th = tid >> 8;
    typedef float f2v __attribute__((ext_vector_type(2)));
    f2v wv[31];
    const float* wp = w_dw + 2 * cp; asm volatile("" : "+v"(wp));
#pragma unroll
    for (int k = 0; k < 31; ++k) wv[k] = *(const f2v*)(wp + k * 512);
    const f2v bias = *(const f2v*)(b_dw + 2 * cp);
    LAS bf16* cbuf = (LAS bf16*)(lds + CONV_CBUF_OFF);
#pragma unroll 1
    for (int pass = 0; pass < 2; ++pass) {
        const int tb = th * 32 + pass * 16;
        f2v a[16];
#pragma unroll
        for (int i = 0; i < 16; ++i) a[i] = bias;
#pragma unroll
        for (int j = 0; j < 46; ++j) { const unsigned xv = *(const LAS unsigned*)(us + (tb + j) * 512 + 2 * cp); const f2v x = (f2v){bflo(xv), bfhi(xv)};
#pragma unroll
            for (int i = 0; i < 16; ++i) if (j - i >= 0 && j - i <= 30) a[i] = __builtin_elementwise_fma(wv[j - i], x, a[i]);
            if ((j & 7) == 7) asm volatile("" ::: "memory"); }
#pragma unroll
        for (int i = 0; i < 16; ++i) *(LAS unsigned*)(cbuf + (th * 16 + i) * 512 + 2 * cp) = pk2(a[i].x, a[i].y);
        __syncthreads();
#pragma unroll
        for (int q = 0; q < 4; ++q) { const int rb = 4 * wave + q, tok = (rb >> 4) * 32 + pass * 16 + (rb & 15);
            const v4u w = *(const LAS v4u*)(cbuf + rb * 512 + lane * 8);
            float v[8] = {bflo(w.x), bfhi(w.x), bflo(w.y), bfhi(w.y), bflo(w.z), bfhi(w.z), bflo(w.w), bfhi(w.w)};
            float s1 = 0.f, s2 = 0.f;
#pragma unroll
            for (int e = 0; e < 8; ++e) { s1 += v[e]; s2 += v[e] * v[e]; }
            s1 = wave_sum(s1); s2 = wave_sum(s2);
            const float mean = s1 * (1.f / 512.f), var = s2 * (1.f / 512.f) - mean * mean, rstd = __builtin_amdgcn_rsqf(var + EPS);
            const f32x4 g0 = *(const f32x4*)(ln_g + lane * 8), g1 = *(const f32x4*)(ln_g + lane * 8 + 4), b0 = *(const f32x4*)(ln_b + lane * 8), b1 = *(const f32x4*)(ln_b + lane * 8 + 4);
#pragma unroll
            for (int e = 0; e < 8; ++e) { const float y = (v[e] - mean) * rstd * (e < 4 ? g0[e] : g1[e - 4]) + (e < 4 ? b0[e] : b1[e - 4]); v[e] = y * fsig(y); }
            v4u o; o.x = pk2(v[0], v[1]); o.y = pk2(v[2], v[3]); o.z = pk2(v[4], v[5]); o.w = pk2(v[6], v[7]);
            *(v4u*)(CB + ((size_t)b * 8192 + t0 + tok) * 768 + lane * 8) = o; }
        __syncthreads();
    }
}
__device__ __forceinline__ void conv_sample(const bf16* U, bf16* CB, const float* state, const float* w_dw, const float* b_dw, const float* ln_g, const float* ln_b, int bs, LAS unsigned char* lds, int tid) {
    const int lane = tid & 63, wave = tid >> 6, ch = tid;
    float x[34];
#pragma unroll
    for (int j = 0; j < 30; ++j) x[j] = state[((size_t)bs * 30 + j) * 512 + ch];
#pragma unroll
    for (int j = 0; j < 4; ++j) x[30 + j] = __uint_as_float((unsigned)U[((size_t)MP + bs * 4 + j) * 512 + ch] << 16);
    float a[4]; const float bias = b_dw[ch];
#pragma unroll
    for (int i = 0; i < 4; ++i) a[i] = bias;
#pragma unroll
    for (int k = 0; k < 31; ++k) { const float w = w_dw[k * 512 + ch];
#pragma unroll
        for (int i = 0; i < 4; ++i) a[i] += w * x[i + k]; }
    LAS float* red = (LAS float*)lds;
#pragma unroll
    for (int i = 0; i < 4; ++i) { const float s1 = wave_sum(a[i]), s2 = wave_sum(a[i] * a[i]); if (lane == 0) { red[(i * 8 + wave) * 2] = s1; red[(i * 8 + wave) * 2 + 1] = s2; } }
    __syncthreads();
    const float g = ln_g[ch], be = ln_b[ch];
#pragma unroll
    for (int i = 0; i < 4; ++i) { float s1 = 0.f, s2 = 0.f;
#pragma unroll
        for (int w = 0; w < 8; ++w) { s1 += red[(i * 8 + w) * 2]; s2 += red[(i * 8 + w) * 2 + 1]; }
        const float mean = s1 * (1.f / 512.f), var = s2 * (1.f / 512.f) - mean * mean, rstd = __builtin_amdgcn_rsqf(var + EPS);
        float y = (a[i] - mean) * rstd * g + be; y *= fsig(y);
        CB[((size_t)MP + bs * 4 + i) * 768 + ch] = (bf16)f2bf(y); }
    __syncthreads();
}
__device__ __forceinline__ const float* samp_row(const float* c0, const float* c1, const float* c2, const float* out, int e, int bs, int tok, float& bias2, int slot) {
    const int g = e >= 258 ? 2 : e >= 129 ? 1 : 0, j = e - 129 * g, sh = 2 * g, W = 128 << sh, idx = W + tok - (j << sh);
    const float* cg = (g == 0) ? c0 : (g == 1) ? c1 : c2;
    const float* og = out + ((g == 0) ? O_KV0S : (g == 1) ? O_KV1S : O_KV2S);
    bias2 = __builtin_amdgcn_exp2f(-8.0f * (float)(4 * g + slot + 1) / 12.0f) * 1.4426950408889634f * (float)(j << sh);
    return (idx >= W) ? og + ((size_t)bs * W + (idx - 4)) * 512 + slot * 64 : cg + ((size_t)bs * W + idx) * 512 + slot * 64;
}
__device__ __forceinline__ float row16_sum(float v) { v += DPPF(v, 0xB1); v += DPPF(v, 0x4E); v += DPPF(v, 0x141); v += DPPF(v, 0x140); return v; }
__device__ __forceinline__ void att_sample_wave(const bf16* Q, bf16* OB, const float* c0, const float* c1, const float* c2, const float* out, int bs, int tok, int slot, int lane) {
    const int kq = lane >> 4, i4 = (lane & 15) * 4;
    const size_t qrow = (size_t)MP + bs * 4 + tok;
    f32x4 q4[3];
#pragma unroll
    for (int g = 0; g < 3; ++g) { const uint2 w = *(const uint2*)(Q + qrow * 768 + 256 * g + 64 * slot + i4); q4[g] = (f32x4){bflo(w.x), bfhi(w.x), bflo(w.y), bfhi(w.y)}; }
    float m = -1e30f, l = 0.f; f32x4 acc = (f32x4){0.f, 0.f, 0.f, 0.f};
    f32x4 kvA[8], vvA[8], kvB[8], vvB[8]; float b2A[8], b2B[8];
#define SAMP_LOAD(KV, VV, B2, S0) do { _Pragma("unroll") for (int t = 0; t < 8; ++t) { const int e = 4 * ((S0) + t) + kq, ec = e < 387 ? e : 386; \
            const float* rp = samp_row(c0, c1, c2, out, ec, bs, tok, B2[t], slot) + i4; KV[t] = *(const f32x4*)rp; VV[t] = *(const f32x4*)(rp + 256); } } while (0)
#define SAMP_STEP(KV, VV, B2, S0) do { _Pragma("unroll") for (int t = 0; t < 8; ++t) { const int e = 4 * ((S0) + t) + kq; \
            const f32x4 qq = e >= 258 ? q4[2] : e >= 129 ? q4[1] : q4[0]; \
            const float d = row16_sum((qq[0] * KV[t][0] + qq[1] * KV[t][1]) + (qq[2] * KV[t][2] + qq[3] * KV[t][3])); \
            const float sv = e < 387 ? d - B2[t] : -INFINITY; \
            const float mnew = fmaxf(m, sv), f = __builtin_amdgcn_exp2f(m - mnew), p = __builtin_amdgcn_exp2f(sv - mnew); \
            l = l * f + p; m = mnew; acc = acc * f + VV[t] * p; } } while (0)
    SAMP_LOAD(kvA, vvA, b2A, 0);
#pragma unroll 1
    for (int s0 = 0; s0 < 104; s0 += 16) {
        if (s0 + 8 < 104) SAMP_LOAD(kvB, vvB, b2B, s0 + 8);
        SAMP_STEP(kvA, vvA, b2A, s0);
        if (s0 + 8 >= 104) break;
        if (s0 + 16 < 104) SAMP_LOAD(kvA, vvA, b2A, s0 + 16);
        SAMP_STEP(kvB, vvB, b2B, s0 + 8);
    }
#undef SAMP_LOAD
#undef SAMP_STEP
    float M = fmaxf(m, __shfl_xor(m, 16)); M = fmaxf(M, __shfl_xor(M, 32));
    const float gsc = __builtin_amdgcn_exp2f(m - M);
    l *= gsc; acc = acc * gsc;
    l += __shfl_xor(l, 16); l += __shfl_xor(l, 32);
#pragma unroll
    for (int e = 0; e < 4; ++e) { acc[e] += __shfl_xor(acc[e], 16); acc[e] += __shfl_xor(acc[e], 32); }
    if (kq == 0) { const float inv = __builtin_amdgcn_rcpf(l);
        uint2 w; w.x = pk2(acc[0] * inv, acc[1] * inv); w.y = pk2(acc[2] * inv, acc[3] * inv);
        *(uint2*)(OB + qrow * 768 + 512 + 64 * slot + i4) = w; }
}
__device__ __forceinline__ void sub_barrier(gu32* cnt, unsigned target, bool arrive = true) {
    asm volatile("s_waitcnt vmcnt(0)" ::: "memory");
    __syncthreads();
    if (threadIdx.x == 0) {
        __builtin_amdgcn_fence(__ATOMIC_RELEASE, "agent");
        asm volatile("s_waitcnt vmcnt(0)" ::: "memory");
        if (arrive) __hip_atomic_fetch_add(cnt, 1u, RLX_AGENT);
        unsigned sp = 0;
        while (__hip_atomic_load(cnt, RLX_AGENT) < target) { __builtin_amdgcn_s_sleep(1); if (++sp > (1u << 22)) break; }
        __builtin_amdgcn_fence(__ATOMIC_ACQUIRE, "agent");
        asm volatile("s_waitcnt vmcnt(0)" ::: "memory");
    }
    __syncthreads();
}

__device__ __forceinline__ void kv_copy(const float* cache0, const float* cache1, const float* cache2, const float* state_conv, float* out, unsigned gt, unsigned GS) {
#pragma unroll
    for (int g = 0; g < 3; ++g) {
        const unsigned W = 128u << (2 * g); const float* cg = g == 0 ? cache0 : g == 1 ? cache1 : cache2;
        float* og = out + (g == 0 ? O_KV0S : g == 1 ? O_KV1S : O_KV2S);
        const unsigned per4 = (W - 4) * 128, tot4 = per4 * 32;
        for (unsigned i0 = gt; i0 < tot4; i0 += 8 * GS) {
            f32x4 v[8];
#pragma unroll
            for (int k = 0; k < 8; ++k) { const unsigned i = i0 + k * GS; if (i < tot4) { const unsigned bs = i / per4, r = i - bs * per4;
                v[k] = __builtin_nontemporal_load((const f32x4*)(cg + ((size_t)bs * W + 4) * 512) + r); } }
#pragma unroll
            for (int k = 0; k < 8; ++k) { const unsigned i = i0 + k * GS; if (i < tot4) { const unsigned bs = i / per4, r = i - bs * per4;
                __builtin_nontemporal_store(v[k], (f32x4*)(og + (size_t)bs * W * 512) + r); } }
        }
    }
    const unsigned per4 = 26 * 128, tot4 = per4 * 32;
    for (unsigned i = gt; i < tot4; i += GS) { const unsigned bs = i / per4, r = i - bs * per4;
        ((f32x4*)(out + O_CONVS + (size_t)bs * 30 * 512))[r] = ((const f32x4*)(state_conv + ((size_t)bs * 30 + 4) * 512))[r]; }
}
#define WS_PTRS(ws) \
    float* rstd0 = (float*)(ws + WS_RSTD0); float* ssq1 = (float*)(ws + WS_SSQ1); float* ssq2 = (float*)(ws + WS_SSQ2); float* ssq3 = (float*)(ws + WS_SSQ3); \
    bf16* Wi_t = (bf16*)(ws + WS_W_IN); bf16* Wm_t = (bf16*)(ws + WS_W_C); bf16* Wo_t = (bf16*)(ws + WS_W_O); \
    bf16* Wu_t = (bf16*)(ws + WS_W_UP); bf16* Wd_t = (bf16*)(ws + WS_W_DN); bf16* Wg_t = (bf16*)(ws + WS_W_PG); bf16* Wp_t = (bf16*)(ws + WS_W_PL); \
    bf16* PB = (bf16*)(ws + WS_PB); bf16* XB = (bf16*)(ws + WS_XB); bf16* CO = (bf16*)(ws + WS_CO); \
    bf16* U = (bf16*)(ws + WS_U); bf16* Qb = (bf16*)(ws + WS_Q); bf16* Kb = (bf16*)(ws + WS_K); bf16* Vb = (bf16*)(ws + WS_V); \
    bf16* MIX = (bf16*)(ws + WS_MIX); bf16* HB = (bf16*)(ws + WS_H); bf16* GT = (bf16*)(ws + WS_GT); bf16* PP = (bf16*)(ws + WS_PP);
__global__ void __launch_bounds__(NTHREADS, 2) mega_fwd(Args args) {
    extern __shared__ __attribute__((aligned(16))) unsigned char lds_raw[];
    LAS unsigned char* lds = (LAS unsigned char*)lds_raw;
    volatile LAS unsigned* MISC = (volatile LAS unsigned*)(lds + MISC_OFF);
    const int tid0 = threadIdx.x; const int wave0 = __builtin_amdgcn_readfirstlane(tid0 >> 6);
    const int G = gridDim.x; const int bx = blockIdx.x; const int vcu = (G % 8 == 0) ? (bx % 8) * (G / 8) + bx / 8 : bx;
    unsigned char* ws = args.ws; float* out = args.out;
    gu32* ctl = (gu32*)(ws + WS_CTL);
    const float* x_prompt = args.in[0]; const float* x_sample = args.in[1]; const float* state_conv = args.in[2];
    const float* cache0 = args.in[3]; const float* cache1 = args.in[4]; const float* cache2 = args.in[5];
    const float* p_prompt = args.in[6]; const float* p_sample = args.in[7];
    const float* g_mix = args.in[8]; const float* w_in = args.in[9]; const float* w_dw = args.in[10]; const float* b_dw = args.in[11];
    const float* ln_g = args.in[12]; const float* ln_b = args.in[13]; const float* w_conv_out = args.in[14]; const float* w_att_out = args.in[15];
    const float* w_out = args.in[16]; const float* g_ffn = args.in[17]; const float* w_ffn_gate = args.in[18]; const float* w_ffn_up = args.in[19];
    const float* w_ffn_down = args.in[20]; const float* g_ple = args.in[21]; const float* w_ple_gate = args.in[22]; const float* w_ple = args.in[23];
    const float* g_final = args.in[24];
    for (int u = tid0; u < (LDS_BYTES - LDSCTL_OFF) / 4; u += NTHREADS) ((LAS unsigned*)(lds + LDSCTL_OFF))[u] = 0u;
    __syncthreads();
    XcdBarrier bar; bar.bar = (unsigned*)(ctl + CW_BAR); bar.x = 0; bar.st = nullptr; bar.gsize = 0u;
    if (N_LAUNCHES == 1) bar = xcd_barrier_post((unsigned*)(ctl + CW_BAR), MISC + 8);
    XcdBarrier gbar = xcd_barrier_post((unsigned*)(ctl + CW_GBAR) + (blockIdx.x & 15) * XCD_BAR_WORDS, MISC + 12); gbar.gsize = gridDim.x / 16;
    const bool is_smp = blockIdx.x < 32;
    XcdBarrier rbar = xcd_barrier_post((unsigned*)(ctl + (is_smp ? CW_SBAR : CW_PBAR)), MISC + 16); rbar.gsize = is_smp ? 32u : gridDim.x - 32u;
#define ROLE_BAR() do { XcdBarrier b4_ = rbar; asm volatile("" : "+s"(b4_.bar)); xcd_barrier(b4_); } while (0)
#define GROUP_BAR() do { XcdBarrier b3_ = gbar; asm volatile("" : "+s"(b3_.bar)); xcd_barrier(b3_); } while (0)
#define GRID_BAR() do { if (N_LAUNCHES == 1) { XcdBarrier b2_ = bar; asm volatile("" : "+s"(b2_.bar)); xcd_barrier(b2_); } } while (0)
    const int lo = args.ph_lo, hi = args.ph_hi;
#ifdef PROBE_TS
    unsigned long long* tsw = (unsigned long long*)(ctl + 12288); int nstamp = 0;
#ifndef TS_BLOCK
#define TS_BLOCK 0
#endif
#define STAMP() do { if (bx == TS_BLOCK && wave0 == 0 && __builtin_amdgcn_mbcnt_hi(~0u, __builtin_amdgcn_mbcnt_lo(~0u, 0u)) == 0) tsw[nstamp] = __builtin_amdgcn_s_memrealtime(); ++nstamp; } while (0)
#else
#define STAMP() do {} while (0)
#endif
    STAMP();
#ifndef PH_MASK
#define PH_MASK 0x1ff
#endif
#define IN(k) ((((PH_MASK) >> (k)) & 1) && lo <= (k) && (k) < hi)
#define BOTH(k) (IN(k) && IN((k) + 1))
#ifndef PROBE_DBL
#define PROBE_DBL 0
#endif
#ifndef ATT_REP
#define ATT_REP 1
#endif
#ifndef CONV_REP
#define CONV_REP 1
#endif
#ifndef SAMP_REP
#define SAMP_REP 1
#endif
#ifndef W_REP
#define W_REP 1
#endif
#ifndef ROW_REP
#define ROW_REP 1
#endif
#ifndef COPY_REP
#define COPY_REP 1
#endif
#ifndef PPB_PANELS
#define PPB_PANELS 64
#endif
#ifndef SKIP_MASK
#define SKIP_MASK 0
#endif
#define NREP(k) ((((PROBE_DBL) >> (k)) & 1) ? 2 : 1)
    const int NGW = G * NWAVES; constexpr int NSWG = 32, CW_GRP = 8448, CW_SB = 8192, CW_PG = 8320, CW_Q = 8384, CW_TMO2 = 8256, CW_PCNT = 16384, LASTPH = 7;
#define PH_IDS() unsigned z_ = 0u; asm volatile("" : "+s"(z_)); int tid_ = wave0 * 64 + (int)__builtin_amdgcn_mbcnt_hi(~0u, __builtin_amdgcn_mbcnt_lo(~0u, z_)); asm volatile("" : "+v"(tid_)); const int tid = tid_, lane = tid & 63, wave = __builtin_amdgcn_readfirstlane(tid >> 6), gw = vcu * NWAVES + wave; (void)lane; (void)gw

    constexpr int I_IN = 16 * (NIN / 32), I_C = 8 * 32, I_A = 4 * 32, I_O = 16 * 32, I_U = 16 * (2 * DFF / 32), I_D = (DFF / 64) * 32, I_G = 16 * 32, I_P = 4 * 32;
    constexpr int NITEMS = I_IN + I_C + I_A + I_O + I_U + I_D + I_G + I_P;
#define W_ITEM(it_) do { int r = (it_); \
        if (r < I_IN) { const int nblk = NIN / 32, kb = r / nblk, nb = r % nblk, R = 32 * nb, pn = R >> 8, cc = R & 255; \
            const int csrc = pn < 4 ? (cc < 128 ? 128 * pn + cc : 512 + 128 * pn + (cc - 128)) : pn < 13 ? R : (cc < 128 ? 3328 + 128 * (pn - 13) + cc : 4352 + 128 * (pn - 13) + (cc - 128));   \
            p0_transpose_item(w_in, NIN, 64 * kb, csrc, Wi_t, 1024, R, g_mix, scr, lane); } \
        else if ((r -= I_IN) < I_C) { p0_mat_item(w_conv_out, 512, 1024, 0, 1024, Wm_t, 768, 0, nullptr, scr, r, lane); } \
        else if ((r -= I_C) < I_A) { p0_mat_item(w_att_out, 256, 1024, 0, 1024, Wm_t, 768, 0, nullptr, scr, r, lane, 512); } \
        else if ((r -= I_A) < I_O) { p0_mat_item(w_out, 1024, 1024, 0, 1024, Wo_t, 1024, 0, nullptr, scr, r, lane); } \
        else if ((r -= I_O) < I_U) { const int nblk = 2 * DFF / 32, kb = r / nblk, nb = r % nblk, R = 32 * nb, pn = R >> 8, cc = R & 255; \
            const float* src = cc < 128 ? w_ffn_gate : w_ffn_up; const int csrc = 128 * pn + (cc & 127); \
            p0_transpose_item(src, DFF, 64 * kb, csrc, Wu_t, 1024, R, g_ffn, scr, lane); } \
        else if ((r -= I_U) < I_D) { p0_mat_item(w_ffn_down, DFF, 1024, 0, 1024, Wd_t, DFF, 0, nullptr, scr, r, lane); } \
        else if ((r -= I_D) < I_G) { p0_mat_item(w_ple_gate, 1024, 1024, 0, 1024, Wg_t, 1024, 0, g_ple, scr, r, lane); } \
        else { r -= I_G; p0_mat_item(w_ple, 256, 1024, 0, 1024, Wp_t, 256, 0, nullptr, scr, r, lane); } } while (0)
    if (IN(0)) for (int rep_ = 0; rep_ < NREP(0); ++rep_) {
        PH_IDS();
        unsigned char* wsl = ws; asm volatile("" : "+s"(wsl)); WS_PTRS(wsl)
        LAS float* scr = (LAS float*)(lds + wave * 16384);
        for (int j = gw; j < I_IN + I_P; j += NGW) { W_ITEM(j < I_IN ? j : (NITEMS - I_P) + (j - I_IN)); }
        for (int r2_ = 0; r2_ < ROW_REP; ++r2_)
        for (int m = gw; m < MPAD; m += NGW) {
            GAS unsigned long long* xo = (GAS unsigned long long*)(XB + (size_t)m * 1024) + lane;
            GAS unsigned long long* po = (GAS unsigned long long*)(PB + (size_t)m * 256) + lane;
            if (m < MR) {
                const float* xr = m < MP ? x_prompt + (size_t)m * 1024 : x_sample + (size_t)(m - MP) * 1024;
                const float* pr = m < MP ? p_prompt + (size_t)m * 256 : p_sample + (size_t)(m - MP) * 256;
                f32x4 v[4]; float s = 0.f;
#pragma unroll
                for (int j = 0; j < 4; ++j) { v[j] = __builtin_nontemporal_load((const GAS f32x4*)xr + lane + 64 * j);     s += (v[j][0] * v[j][0] + v[j][1] * v[j][1]) + (v[j][2] * v[j][2] + v[j][3] * v[j][3]); }
                const f32x4 pv = __builtin_nontemporal_load((const GAS f32x4*)pr + lane);
                s = wave_sum(s);
                if (lane == 0) rstd0[m] = __builtin_amdgcn_rsqf(s * (1.f / 1024.f) + EPS);
#pragma unroll
                for (int j = 0; j < 4; ++j) xo[64 * j] = (unsigned long long)pk2(v[j][0], v[j][1]) | ((unsigned long long)pk2(v[j][2], v[j][3]) << 32);
                po[0] = (unsigned long long)pk2(pv[0], pv[1]) | ((unsigned long long)pk2(pv[2], pv[3]) << 32);
            } else {
                if (lane == 0) rstd0[m] = 0.f;
#pragma unroll
                for (int j = 0; j < 4; ++j) xo[64 * j] = 0ull;
                po[0] = 0ull;
            }
        }
        if (BOTH(0) || rep_ + 1 < NREP(0)) GRID_BAR();
    }
    STAMP();

    enum { MODE_S = 0, MODE_PS = 1, MODE_ALL = 2, MODE_GA = 3, MODE_GB = 4 };
    const int grp = (bx >> 3) & 1, cg = bx >> 4; unsigned ggen = 0;
    int mode = (bx < NSWG) ? MODE_S : MODE_PS, phase = (bx < NSWG) ? 0 : 1; unsigned sbgen = 0; bool rep_done = false;
    gu32* sbcnt = ctl + CW_SB;
#ifdef PROBE_TS2
    if (bx == 0 && wave0 == 0 && __builtin_amdgcn_mbcnt_hi(~0u, __builtin_amdgcn_mbcnt_lo(~0u, 0u)) == 0) ((unsigned long long*)(ctl + 12288))[32] = __builtin_amdgcn_s_memrealtime();
#endif
    for (;;) {
        unsigned char* wsl = ws; asm volatile("" : "+s"(wsl)); WS_PTRS(wsl)
        int pm0, nMt, Gm, cm, vcm;
        bf16 *COm = CO, *MIXm = MIX, *HBm = HB;
        if (mode == MODE_S) { pm0 = MP / 256; nMt = 1; Gm = NSWG; cm = bx; vcm = bx;
            COm = (bf16*)(wsl + WS_SMP_CO) - (size_t)MP * 768; MIXm = (bf16*)(wsl + WS_SMP_MIX) - (size_t)MP * 1024;
            HBm = (bf16*)(wsl + WS_SMP_H) - (size_t)MP * DFF; }
        else if (mode == MODE_PS) { pm0 = 0; nMt = MP / 256; Gm = G - NSWG; cm = bx - NSWG; vcm = cm; }
        else if (mode == MODE_ALL) { pm0 = 0; nMt = MP / 256; Gm = G; cm = bx; vcm = vcu; }
        else { pm0 = 8 * (bx & 7) + ((mode == MODE_GB) ? 64 : 0); nMt = 8; Gm = G / 16; cm = cg; vcm = cg; }
        const bool p4 = (mode == MODE_GA || mode == MODE_GB);
        const int ph = (phase == 3 && ((mode == MODE_PS) || (mode == MODE_S && cm >= 4 && cm < 8))) ? 8 : (mode == MODE_S && ((phase == 3 && cm >= 8) || (phase == 4 && cm >= 4))) ? 9 : phase;
        switch (ph) {
        case 0: {
            PH_IDS(); LAS float* scr = (LAS float*)(lds + wave * 16384);
            for (int j = I_IN + cm * NWAVES + wave; j < I_IN + I_C + I_A; j += NSWG * NWAVES) { W_ITEM(j); }
        } break;
        case 9: {
            PH_IDS(); LAS float* scr = (LAS float*)(lds + wave * 16384);
            const int w0 = (phase == 3) ? 8 : 4, jlo = (phase == 3) ? I_IN + I_C + I_A : I_IN + I_C + I_A + I_O + I_U, jhi = (phase == 3) ? I_IN + I_C + I_A + I_O + I_U : NITEMS - I_P;
            for (int j = jlo + (cm - w0) * NWAVES + wave; j < jhi; j += (NSWG - w0) * NWAVES) { W_ITEM(j); }
        } break;
        case 1: if (!((SKIP_MASK >> 1) & 1)) {
            pg8::Gemm g{XB, Wi_t, MPAD, NIN, 1024, 1024}; pg8::RangeOrder S; S.init(pm0, nMt, NIN, Gm, cm);
            pg8::EpiIn E{rstd0, U, Qb, Kb, Vb, GT, out};
            pg8::gemm_phase<pg8::EpiIn, pg8::RangeOrder, true, true>(lds, g, S, E, wave0);
        } break;
        case 2: if (!((SKIP_MASK >> 2) & 1)) {
            PH_IDS();
            if (mode == MODE_S) {
                conv_sample(U, COm, state_conv, w_dw, b_dw, ln_g, ln_b, cm, lds, tid);
#pragma unroll 1
                for (int r = 0; r < 2; ++r) { const int j = cm * 16 + r * 8 + wave;
#ifndef NO_SAMPATT
                    att_sample_wave(Qb, COm, cache0, cache1, cache2, out, j >> 4, (j >> 2) & 3, j & 3, lane);
#endif
                }
            } else {
                LAS int* qit = (LAS int*)(lds + LDSCTL_OFF + 64);
                for (;;) {
                    __syncthreads();
                    if (tid == 0) qit[0] = (int)__hip_atomic_fetch_add(ctl + CW_Q, 1u, RLX_AGENT);
                    __syncthreads();
                    const int it = __builtin_amdgcn_readfirstlane(qit[0]);
                    if (it >= 768) break;
                    unsigned zq_ = 0u; asm volatile("" : "+s"(zq_)); int tq = wave0 * 64 + (int)__builtin_amdgcn_mbcnt_hi(~0u, __builtin_amdgcn_mbcnt_lo(~0u, zq_)); asm volatile("" : "+v"(tq));
#ifdef PROBE_Q
                    const unsigned long long q0_ = __builtin_amdgcn_s_memrealtime();
#endif
                    if (it < 256) {
                        int b_, slot_, sp_; if (it < 240) { b_ = it / 60; const int r_ = it - 60 * b_; slot_ = r_ / 15; sp_ = 1 + (r_ - 15 * slot_); } else { b_ = (it - 240) >> 2; slot_ = (it - 240) & 3; sp_ = 0; }
                        att_unit2(Qb, Kb, Vb, COm, b_, slot_, sp_, lds, tq); }
                    else { const int ti = it - 256; conv_tile(U, COm, w_dw, b_dw, ln_g, ln_b, ti >> 7, (ti & 127) * 64, lds, tq); }
#ifdef PROBE_Q
                    asm volatile("s_waitcnt vmcnt(0)" ::: "memory");
                    if (bx == TS_BLOCK && wave0 == 0 && __builtin_amdgcn_mbcnt_hi(~0u, __builtin_amdgcn_mbcnt_lo(~0u, 0u)) == 0) { const int sl_ = it < 256 ? 21 : 20; if (tsw[sl_] == 0) tsw[sl_] = __builtin_amdgcn_s_memrealtime() - q0_; }
#endif
                }
            }
        } break;
        case 3: if (!((SKIP_MASK >> 3) & 1)) {
            int k3 = 768; asm volatile("" : "+s"(k3));
            pg8::Gemm g{COm, Wm_t, MPAD, 1024, k3, k3}; pg8::RangeOrder S; S.init(pm0, nMt, 1024, Gm, cm, p4); pg8::EpiMix E{GT, MIXm};
            pg8::gemm_phase<pg8::EpiMix, pg8::RangeOrder, true, true>(lds, g, S, E, wave0);
        } break;
        case 8: {
            int k8 = 256; asm volatile("" : "+s"(k8));
            pg8::Gemm g{PB, Wp_t, MPAD, 1024, k8, k8}; pg8::RangeOrder S; S.init(pm0, mode == MODE_PS ? 64 : nMt, 1024, mode == MODE_S ? 4 : Gm, mode == MODE_S ? cm - 4 : cm, p4); pg8::EpiGate E{nullptr, 0, PP};
            pg8::gemm_phase<pg8::EpiGate, pg8::RangeOrder, true, true>(lds, g, S, E, wave0);
        } break;
        case 4: if (!((SKIP_MASK >> 4) & 1)) {
            pg8::Gemm g{MIXm, Wo_t, MPAD, 1024, 1024, 1024}; pg8::RangeOrder S; S.init(pm0, nMt, 1024, Gm, cm, p4); pg8::EpiResidIn E{x_prompt, x_sample, XB, ssq1};
            pg8::gemm_phase<pg8::EpiResidIn, pg8::RangeOrder, true, true>(lds, g, S, E, wave0);
        } break;
        case 5: if (!((SKIP_MASK >> 5) & 1)) {
            pg8::Gemm g{XB, Wu_t, MPAD, 2 * DFF, 1024, 1024}; pg8::RangeOrder S; S.init(pm0, nMt, 2 * DFF, Gm, cm, p4); pg8::EpiUp E{ssq1, HBm, cache0, cache1, cache2, state_conv, out};
            pg8::gemm_phase<pg8::EpiUp, pg8::RangeOrder, true, true>(lds, g, S, E, wave0);
#ifdef PROBE_NULLEPI
            if (mode == MODE_ALL) { GRID_BAR(); pg8::EpiNull E0{}; pg8::gemm_phase<pg8::EpiNull, pg8::RangeOrder, true, true>(lds, g, S, E0, wave0); }
#endif
        } break;
        case 6: if (!((SKIP_MASK >> 6) & 1)) {
            pg8::Gemm g{HBm, Wd_t, MPAD, 1024, DFF, DFF}; pg8::RangeOrder S; S.init(pm0, nMt, 1024, Gm, cm, p4); pg8::EpiResidB E{XB, ssq2};
            pg8::gemm_phase<pg8::EpiResidB, pg8::RangeOrder, true, true>(lds, g, S, E, wave0);
        } break;
        case 7: if (!((SKIP_MASK >> 7) & 1)) {
            { pg8::Gemm g{XB, Wg_t, MPAD, 1024, 1024, 1024}; pg8::RangeOrder S; S.init(pm0, nMt, 1024, Gm, cm, p4); pg8::EpiPleNorm E{ssq2, PP, XB, out, ssq3, (unsigned*)(ctl + CW_PCNT), g_final, (unsigned*)(ctl + CW_TMO2), (LAS float*)(lds + LDSCTL_OFF + 4096)};
              pg8::gemm_phase<pg8::EpiPleNorm, pg8::RangeOrder, true, true>(lds, g, S, E, wave0); }
        } break;
        default: break;
        }
#ifdef PROBE_TS2
        { const bool l0 = wave0 == 0 && __builtin_amdgcn_mbcnt_hi(~0u, __builtin_amdgcn_mbcnt_lo(~0u, 0u)) == 0; unsigned long long* t2 = (unsigned long long*)(ctl + 12288) + 32;
          asm volatile("s_waitcnt vmcnt(0)" ::: "memory");
          if (l0 && bx == 0 && mode == MODE_S) t2[phase] = __builtin_amdgcn_s_memrealtime();
          if (l0 && bx == 32 && mode == MODE_PS) t2[phase == 1 ? 8 : 9] = __builtin_amdgcn_s_memrealtime(); }
#endif
        if (mode == MODE_ALL) {
            STAMP(); GRID_BAR(); STAMP();
            if (grp) { mode = MODE_GB; phase = 8; } else { mode = MODE_GA; phase = 3; }
        } else if (mode == MODE_GA || mode == MODE_GB) {
            if (phase == 8) { phase = 3; continue; }
            if (phase == LASTPH) break;
            STAMP(); GROUP_BAR(); STAMP(); ++phase;
        } else if (mode == MODE_S) {
            if (phase == LASTPH) { sub_barrier(ctl + CW_PFLAG, 1u, false); STAMP(); mode = MODE_ALL; phase = 2; }
            else if (phase == 0) { __syncthreads(); phase = 1; continue; }
            else if (phase >= 6) { ++sbgen; sub_barrier(sbcnt, sbgen * 4u); ++phase; }
            else { ROLE_BAR();
                if (phase == 5 && cm >= 4) { sub_barrier(ctl + CW_PFLAG, 1u, false); STAMP(); mode = MODE_ALL; phase = 2; continue; }
#ifdef CHAIN_DBL
                if (((CHAIN_DBL >> phase) & 1) && !rep_done) { rep_done = true; continue; }
                rep_done = false;
#endif
                ++phase; }
        } else {
            if (phase == 1) { phase = 3; continue; }
            ROLE_BAR();
            if (cm == 0 && wave0 == 0 && __builtin_amdgcn_mbcnt_hi(~0u, __builtin_amdgcn_mbcnt_lo(~0u, 0u)) == 0) __hip_atomic_store(ctl + CW_PFLAG, 1u, RLX_AGENT);
            STAMP(); mode = MODE_ALL; phase = 2; }
    }
#ifdef PROBE_TS2
    GRID_BAR();
    if (bx == 0 && wave0 == 0 && __builtin_amdgcn_mbcnt_hi(~0u, __builtin_amdgcn_mbcnt_lo(~0u, 0u)) == 0) { unsigned long long* t2 = (unsigned long long*)(ctl + 12288) + 32; out[0] += (float)(((unsigned)(t2[PROBE_TS2] - t2[0]) + 500u) / 1000u) * 10.0f; }
#endif
#ifdef PROBE_TS
    GRID_BAR(); STAMP();
    if (bx == 0 && wave0 == 0 && __builtin_amdgcn_mbcnt_hi(~0u, __builtin_amdgcn_mbcnt_lo(~0u, 0u)) == 0) {
        unsigned long long d = tsw[PROBE_TS] - tsw[PROBE_TS - 1];
#ifdef PROBE_Q
        d = tsw[PROBE_Q];
#endif
#ifdef PROBE_TSUM
        d = 0; for (int k_ = 0; k_ < PROBE_TSUM; ++k_) d += tsw[PROBE_TS + 2 * k_] - tsw[PROBE_TS + 2 * k_ - 1];
#endif
        #ifndef PROBE_QUANT
#define PROBE_QUANT 500u
#endif
        out[0] += (float)(((unsigned)d + PROBE_QUANT / 2) / PROBE_QUANT) * (float)(PROBE_QUANT / 100u); }
#endif
#undef IN
#undef BOTH
#undef GRID_BAR
}

extern "C" void kernel_launch(void* const* d_in, const int* in_sizes, int n_in, void* d_out, int out_size, void* d_ws, size_t ws_size, hipStream_t stream) {
    static int grid = 0;
    if (grid == 0) {
        if (n_in != 25 || (size_t)out_size != O_END || ws_size < WS_END) { fprintf(stderr, "kernel_launch: shape mismatch: n_in %d out %d ws %zu (need %zu)\n", n_in, out_size, ws_size, (size_t)WS_END); grid = -1; return; }
        int dev = 0, cus = 0;
        if (hipGetDevice(&dev) != hipSuccess || hipDeviceGetAttribute(&cus, hipDeviceAttributeMultiprocessorCount, dev) != hipSuccess) { grid = -1; return; }
        if (hipFuncSetAttribute((const void*)mega_fwd, hipFuncAttributeMaxDynamicSharedMemorySize, LDS_BYTES) != hipSuccess) { fprintf(stderr, "kernel_launch: hipFuncSetAttribute failed\n"); grid = -1; return; }
        int per_cu = 0;
        if (hipOccupancyMaxActiveBlocksPerMultiprocessor(&per_cu, (const void*)mega_fwd, NTHREADS, LDS_BYTES) != hipSuccess || per_cu < 1) fprintf(stderr, "kernel_launch: occupancy query says %d\n", per_cu);
        (void)hipGetLastError();
        grid = cus;
    }
    if (grid < 0) return;
    (void)hipMemsetAsync((char*)d_ws + WS_CTL, 0, CTL_ZERO_BYTES, stream);
    Args a{};
    for (int i = 0; i < 25; ++i) a.in[i] = (const float*)d_in[i];
    a.out = (float*)d_out; a.ws = (unsigned char*)d_ws;
    if (N_LAUNCHES == 1) { a.ph_lo = 0; a.ph_hi = NPHASE; if (grid != 256) { fprintf(stderr, "kernel_launch: built for 256 CUs, got %d\n", grid); return; } hipLaunchKernelGGL(mega_fwd, dim3(grid), dim3(NTHREADS), LDS_BYTES, stream, a); }
    else {
#ifdef DBG_DUMP
        for (int li = 0; li <= DBG_DUMP; ++li) { a.ph_lo = li; a.ph_hi = li + 1; hipLaunchKernelGGL(mega_fwd, dim3(grid), dim3(NTHREADS), LDS_BYTES, stream, a); }
        if (DBG_DUMP == 1 || DBG_DUMP == 2 || DBG_DUMP == 3 || DBG_DUMP == 5) { a.ph_lo = 9; a.ph_hi = 10; hipLaunchKernelGGL(mega_fwd, dim3(grid), dim3(NTHREADS), LDS_BYTES, stream, a); }
#else
        for (int li = 0; li < NPHASE; ++li) { a.ph_lo = li; a.ph_hi = li + 1; hipLaunchKernelGGL(mega_fwd, dim3(grid), dim3(NTHREADS), LDS_BYTES, stream, a); }
#endif
    }
}
```
